# Optimizing an MI355X kernel written in HIP

```python
import jax, jax.numpy as jnp
from jax import lax
import numpy as np

D_MODEL = 1024
BATCH = 8
SEQ = 4096
DEPTH = 2

GMLP_WIDTH = D_MODEL
GMLP_GROUPS = 8
GMLP_GROUP_DIM = GMLP_WIDTH // GMLP_GROUPS
CHUNK = 128
LRU_WIDTH = D_MODEL
LRU_HEADS = 8
LRU_HEAD_DIM = LRU_WIDTH // LRU_HEADS
CONV_WIDTH = 4
CONV_LEFT = 1
LRU_C = 8.0
N_DIRS = 2
D_FF = -(-8 * D_MODEL // (3 * 256)) * 256
N_IN = 2 * GMLP_WIDTH + 2 * LRU_WIDTH + 2 * D_MODEL
EPS = 1e-6

kernel_name = "hybrid_gmlp_rglru_encoder"


def _rmsnorm(x, g):
    x32 = x.astype(jnp.float32)
    y = x32 * lax.rsqrt(jnp.mean(x32 * x32, axis=-1, keepdims=True) + EPS)
    return (y * g.astype(jnp.float32)).astype(x.dtype)


def _layernorm(x, g, b):
    x32 = x.astype(jnp.float32)
    mu = jnp.mean(x32, axis=-1, keepdims=True)
    xc = x32 - mu
    y = xc * lax.rsqrt(jnp.mean(xc * xc, axis=-1, keepdims=True) + EPS)
    return (y * g.astype(jnp.float32) + b.astype(jnp.float32)).astype(x.dtype)


def _blockdiag(x, w, b):
    B, S, _ = x.shape
    xh = x.reshape(B, S, LRU_HEADS, LRU_HEAD_DIM)
    y = jnp.einsum('bshc,hcd->bshd', xh, w.astype(x.dtype))
    return y.reshape(B, S, LRU_WIDTH) + b.astype(x.dtype)


def _lin_combine(left, right):
    a1, b1 = left
    a2, b2 = right
    return a1 * a2, a2 * b1 + b2


def _rglru_scan(x32, w_r, b_r, w_i, b_i, lam, reverse):
    r = jax.nn.sigmoid(_blockdiag(x32, w_r, b_r))
    i = jax.nn.sigmoid(_blockdiag(x32, w_i, b_i))
    log_a = -LRU_C * r * jax.nn.softplus(-lam.astype(jnp.float32))
    a = jnp.exp(log_a)
    mult = jnp.sqrt(jnp.maximum(-jnp.expm1(2.0 * log_a), 0.0))
    bt = mult * (i * x32)
    _, h = lax.associative_scan(_lin_combine, (a, bt), axis=1, reverse=reverse)
    return h


def _gmlp_branch(zu, zv, ln_g, ln_b, w_s, b_s):
    B, S, _ = zu.shape
    u = jax.nn.gelu(zu)
    v = _layernorm(jax.nn.gelu(zv), ln_g, ln_b)
    vc = v.reshape(B, S // CHUNK, CHUNK, GMLP_GROUPS, GMLP_GROUP_DIM)
    mixed = jnp.einsum('gpq,bnqgc->bnpgc', w_s.astype(v.dtype), vc)
    mixed = mixed + b_s.T.astype(v.dtype)[None, None, :, :, None]
    return u * mixed.reshape(B, S, GMLP_WIDTH)


def _rglru_branch(zx, zg, conv_w, conv_b, w_r, b_r, w_i, b_i, lam):
    S = zx.shape[1]
    xp = jnp.pad(zx, ((0, 0), (CONV_LEFT, CONV_WIDTH - 1 - CONV_LEFT), (0, 0)))
    xc = conv_b.astype(zx.dtype) + sum(xp[:, k:k + S] * conv_w[k].astype(zx.dtype) for k in range(CONV_WIDTH))
    x32 = xc.astype(jnp.float32)
    h = (_rglru_scan(x32, w_r[0], b_r[0], w_i[0], b_i[0], lam[0], False)
         + _rglru_scan(x32, w_r[1], b_r[1], w_i[1], b_i[1], lam[1], True))
    return h.astype(zx.dtype) * jax.nn.gelu(zg)


def setup_inputs(seed: int = 0) -> dict:
    key = jax.random.key(seed)
    ks = jax.random.split(key, 24)
    f32 = jnp.float32
    nrm = lambda k, shape, s: jax.random.normal(k, shape, f32) * s
    L = DEPTH
    x = jax.random.normal(ks[0], (BATCH, SEQ, D_MODEL), f32)
    norm1_g = 1.0 + nrm(ks[1], (L, D_MODEL), 0.05)
    w_in = nrm(ks[2], (L, D_MODEL, N_IN), D_MODEL ** -0.5)
    gmlp_ln_g = 1.0 + nrm(ks[3], (L, GMLP_WIDTH), 0.05)
    gmlp_ln_b = nrm(ks[4], (L, GMLP_WIDTH), 0.05)
    gmlp_w_s = nrm(ks[5], (L, GMLP_GROUPS, CHUNK, CHUNK), CHUNK ** -0.5)
    gmlp_b_s = 1.0 + nrm(ks[6], (L, GMLP_GROUPS, CHUNK), 0.1)
    conv_w = nrm(ks[7], (L, CONV_WIDTH, LRU_WIDTH), CONV_WIDTH ** -0.5)
    conv_b = nrm(ks[8], (L, LRU_WIDTH), 0.02)
    lru_w_r = nrm(ks[9], (L, N_DIRS, LRU_HEADS, LRU_HEAD_DIM, LRU_HEAD_DIM), LRU_HEAD_DIM ** -0.5)
    lru_b_r = nrm(ks[10], (L, N_DIRS, LRU_WIDTH), 0.02)
    lru_w_i = nrm(ks[11], (L, N_DIRS, LRU_HEADS, LRU_HEAD_DIM, LRU_HEAD_DIM), LRU_HEAD_DIM ** -0.5)
    lru_b_i = nrm(ks[12], (L, N_DIRS, LRU_WIDTH), 0.02)
    a_c = jax.random.uniform(ks[13], (L, N_DIRS, LRU_WIDTH), f32, 0.9, 0.999)
    a0 = a_c ** (1.0 / LRU_C)
    lru_lambda = jnp.log(a0) - jnp.log1p(-a0)
    w_out = nrm(ks[14], (L, D_MODEL, D_MODEL), D_MODEL ** -0.5)
    norm2_g = 1.0 + nrm(ks[15], (L, D_MODEL), 0.05)
    w_ffn_in = nrm(ks[16], (L, D_MODEL, 2 * D_FF), D_MODEL ** -0.5)
    w_ffn_out = nrm(ks[17], (L, D_FF, D_MODEL), D_FF ** -0.5)
    final_g = 1.0 + nrm(ks[18], (D_MODEL,), 0.05)
    return {"x": x, "norm1_g": norm1_g, "w_in": w_in, "gmlp_ln_g": gmlp_ln_g,
            "gmlp_ln_b": gmlp_ln_b, "gmlp_w_s": gmlp_w_s, "gmlp_b_s": gmlp_b_s,
            "conv_w": conv_w, "conv_b": conv_b, "lru_w_r": lru_w_r, "lru_b_r": lru_b_r,
            "lru_w_i": lru_w_i, "lru_b_i": lru_b_i, "lru_lambda": lru_lambda,
            "w_out": w_out, "norm2_g": norm2_g, "w_ffn_in": w_ffn_in,
            "w_ffn_out": w_ffn_out, "final_g": final_g}


def reference(x, norm1_g, w_in, gmlp_ln_g, gmlp_ln_b, gmlp_w_s, gmlp_b_s, conv_w, conv_b,
              lru_w_r, lru_b_r, lru_w_i, lru_b_i, lru_lambda, w_out, norm2_g, w_ffn_in,
              w_ffn_out, final_g):
    c0 = GMLP_WIDTH
    c1 = 2 * GMLP_WIDTH
    c2 = c1 + LRU_WIDTH
    c3 = c2 + LRU_WIDTH
    c4 = c3 + D_MODEL
    for l in range(DEPTH):
        h = _rmsnorm(x, norm1_g[l])
        z = h @ w_in[l].astype(h.dtype)
        y_a = _gmlp_branch(z[..., :c0], z[..., c0:c1], gmlp_ln_g[l], gmlp_ln_b[l],
                           gmlp_w_s[l], gmlp_b_s[l])
        y_b = _rglru_branch(z[..., c1:c2], z[..., c2:c3], conv_w[l], conv_b[l],
                            lru_w_r[l], lru_b_r[l], lru_w_i[l], lru_b_i[l], lru_lambda[l])
        merged = jax.nn.sigmoid(z[..., c3:c4]) * y_a + jax.nn.sigmoid(z[..., c4:]) * y_b
        x = x + merged @ w_out[l].astype(merged.dtype)
        h = _rmsnorm(x, norm2_g[l])
        gu = h @ w_ffn_in[l].astype(h.dtype)
        ff = jax.nn.silu(gu[..., :D_FF]) * gu[..., D_FF:]
        x = x + ff @ w_ffn_out[l].astype(ff.dtype)
    return _rmsnorm(x, final_g)
```

```cpp
#include <hip/hip_runtime.h>
#include <hip/hip_cooperative_groups.h>
#include <cstdio>
#include <cstdint>
namespace cg = cooperative_groups;
namespace pg8 {
#define PG8_LAS __attribute__((address_space(3)))
typedef unsigned short bf16_t;
typedef short bf16x8 __attribute__((ext_vector_type(8)));
typedef float f32x4 __attribute__((ext_vector_type(4)));
typedef unsigned u32x4 __attribute__((ext_vector_type(4)));
constexpr int BM = 256, BK = 64, HALF = 128, HTB = HALF * BK * 2  , STAGE_BYTES = 8 * HTB, NXCD = 8, WGM = 8;

__host__ __device__ __forceinline__ int lds_byte(int r, int c) { const int st = (r >> 4) * 2 + (c >> 5), rr = r & 15, cc = c & 31, ob = rr * 64 + cc * 2; return st * 1024 + (ob ^ (((ob >> 9) & 1) << 5)); }
__host__ __device__ __forceinline__ void stage_rc(int b, int& R, int& C) { const int st = b / 1024, sb = b % 1024, swz = sb ^ (((sb >> 9) & 1) << 5); R = (st >> 1) * 16 + swz / 64; C = (st & 1) * 32 + (swz % 64) / 2; }
__host__ __device__ __forceinline__ int perm32(int rho) { const int n = rho >> 4, i = rho & 15; return 8 * (i >> 2) + 4 * n + (i & 3); }

struct Unit { int pm, pn; };
struct Gemm { const bf16_t* A; const bf16_t* Bt; int M, N, K; };

struct StaticOrder {
    int nM, nN, nwg, G, c;
    __host__ __device__ void init(int M, int N, int G_, int c_) { nM = M / BM; nN = N / BM; nwg = nM * nN; G = G_; c = c_; }
    __host__ __device__ bool next(int i, Unit& u) const {
        const long L = (long)i * G + c; if (L >= nwg) return false;
        int wgid = (int)L; { const int q = nwg / NXCD, r = nwg % NXCD, xcd = wgid % NXCD, off = wgid / NXCD; wgid = (xcd < r ? xcd * (q + 1) : r * (q + 1) + (xcd - r) * q) + off; }
        const int nig = WGM * nN, gid = wgid / nig, fm = gid * WGM, gsz = (nM - fm) < WGM ? (nM - fm) : WGM;
        u.pm = fm + ((wgid % nig) % gsz); u.pn = (wgid % nig) / gsz; return true;
    }
    __device__ __forceinline__ void a_ready(const Unit&) const {}
    __device__ __forceinline__ void done(const Unit&) const {}
};
__device__ __forceinline__ unsigned cvt_pk_bf16(float lo, float hi) { unsigned r; asm volatile("v_cvt_pk_bf16_f32 %0, %1, %2" : "=v"(r) : "v"(lo), "v"(hi)); return r; }
typedef float f32x2 __attribute__((ext_vector_type(2)));
typedef unsigned u32x2 __attribute__((ext_vector_type(2)));
__device__ __forceinline__ float sigm(float x) { return __builtin_amdgcn_rcpf(1.0f + __expf(-x)); }
__device__ __forceinline__ float gelu_t(float x) { const float t = 1.5957691216057308f * (x + 0.044715f * x * x * x); return x * sigm(t); }
constexpr float RMS_EPS = 1e-6f;

struct EpiIn {
    static constexpr bool PERM = true, AFTER_DRAIN = false;
    bf16_t* Z; const float* rowss;
    __device__ __forceinline__ void operator()(const f32x4 (&acc)[2][2][4][2], const Unit& u, int wr, int wc, int fr, int fq) const {
        const int pn = u.pn; int type, outcol;
        if (pn < 8) { type = 0; outcol = 128 * pn; } else if (pn < 12) { type = 1; outcol = 1024 + 256 * (pn - 8); } else if (pn < 16) { type = 2; outcol = 2048 + 256 * (pn - 12); } else { type = 3; outcol = 3072 + 128 * (pn - 16); }
        const int row0 = u.pm * BM + wr * 64 + fr;
#pragma unroll
        for (int ai = 0; ai < 2; ++ai)
#pragma unroll
            for (int m = 0; m < 4; ++m) {
                const int row = row0 + ai * HALF + m * 16;
                const float s = __builtin_amdgcn_rsqf(rowss[row] * (1.0f / 1024.0f) + RMS_EPS);
                bf16_t* rowp = Z + (size_t)row * 4096 + outcol + wc * 32 + 8 * fq;
                if (type == 0 || type == 3) {
                    const f32x4 a0 = acc[ai][0][m][0] * s, a1 = acc[ai][0][m][1] * s, g0 = acc[ai][1][m][0] * s, g1 = acc[ai][1][m][1] * s;
                    float o[8];
#pragma unroll
                    for (int j = 0; j < 4; ++j) { o[j] = gelu_t(a0[j]) * sigm(g0[j]); o[4 + j] = gelu_t(a1[j]) * sigm(g1[j]); }
                    u32x4 w; w.x = cvt_pk_bf16(o[0], o[1]); w.y = cvt_pk_bf16(o[2], o[3]); w.z = cvt_pk_bf16(o[4], o[5]); w.w = cvt_pk_bf16(o[6], o[7]);
                    *(u32x4*)rowp = w;
                } else {
#pragma unroll
                    for (int bj = 0; bj < 2; ++bj) {
                        f32x4 v0 = acc[ai][bj][m][0] * s, v1 = acc[ai][bj][m][1] * s;
                        if (type == 1) {
#pragma unroll
                            for (int j = 0; j < 4; ++j) { v0[j] = gelu_t(v0[j]); v1[j] = gelu_t(v1[j]); }
                        }
                        u32x4 w; w.x = cvt_pk_bf16(v0[0], v0[1]); w.y = cvt_pk_bf16(v0[2], v0[3]); w.z = cvt_pk_bf16(v1[0], v1[1]); w.w = cvt_pk_bf16(v1[2], v1[3]);
                        *(u32x4*)(rowp + bj * HALF) = w;
                    }
                }
                asm volatile("" ::: "memory");
            }
    }
};
struct EpiFfn {
    static constexpr bool PERM = true, AFTER_DRAIN = false;
    bf16_t* F; const float* rowss;
    __device__ __forceinline__ void operator()(const f32x4 (&acc)[2][2][4][2], const Unit& u, int wr, int wc, int fr, int fq) const {
        const int row0 = u.pm * BM + wr * 64 + fr;
#pragma unroll
        for (int ai = 0; ai < 2; ++ai)
#pragma unroll
            for (int m = 0; m < 4; ++m) {
                const int row = row0 + ai * HALF + m * 16;
                const float s = __builtin_amdgcn_rsqf(rowss[row] * (1.0f / 1024.0f) + RMS_EPS);
                bf16_t* rowp = F + (size_t)row * 2816 + 128 * u.pn + wc * 32 + 8 * fq;
                const f32x4 a0 = acc[ai][0][m][0] * s, a1 = acc[ai][0][m][1] * s, g0 = acc[ai][1][m][0] * s, g1 = acc[ai][1][m][1] * s;
                float o[8];
#pragma unroll
                for (int j = 0; j < 4; ++j) { o[j] = a0[j] * sigm(a0[j]) * g0[j]; o[4 + j] = a1[j] * sigm(a1[j]) * g1[j]; }
                u32x4 w; w.x = cvt_pk_bf16(o[0], o[1]); w.y = cvt_pk_bf16(o[2], o[3]); w.z = cvt_pk_bf16(o[4], o[5]); w.w = cvt_pk_bf16(o[6], o[7]);
                *(u32x4*)rowp = w;
                asm volatile("" ::: "memory");
            }
    }
};
struct EpiRes {
    static constexpr bool PERM = false, AFTER_DRAIN = false;
    const float* base; float* out; bf16_t* xb; float* rowss;
    __device__ __forceinline__ void operator()(const f32x4 (&acc)[2][2][4][2], const Unit& u, int wr, int wc, int fr, int fq) const {
        const int row0 = u.pm * BM + wr * 64 + fr, col0 = u.pn * BM + wc * 32 + 4 * fq;
#pragma unroll
        for (int ai = 0; ai < 2; ++ai)
#pragma unroll
            for (int m = 0; m < 4; ++m) {
                const int row = row0 + ai * HALF + m * 16; const size_t off = (size_t)row * 1024 + col0; float ss = 0.f;
#pragma unroll
                for (int bj = 0; bj < 2; ++bj)
#pragma unroll
                    for (int n = 0; n < 2; ++n) {
                        const f32x4 bs = *(const f32x4*)(base + off + bj * HALF + n * 16); const f32x4 o = bs + acc[ai][bj][m][n];
                        *(f32x4*)(out + off + bj * HALF + n * 16) = o; ss += (o[0] * o[0] + o[1] * o[1]) + (o[2] * o[2] + o[3] * o[3]);
                        u32x2 w; w.x = cvt_pk_bf16(o[0], o[1]); w.y = cvt_pk_bf16(o[2], o[3]); *(u32x2*)(xb + off + bj * HALF + n * 16) = w;
                    }
                ss += __shfl_xor(ss, 16); ss += __shfl_xor(ss, 32);
                if (fq == 0) atomicAdd(rowss + row, ss);
                asm volatile("" ::: "memory");
            }
    }
};
template <class Epi, class Sched, bool ALIGN_EPI = false, bool SP2 = false>
__device__ __forceinline__ void gemm_phase(PG8_LAS unsigned char* lds, const Gemm g, const Sched& S, const Epi& E) {
    int tid_l = threadIdx.x; asm volatile("" : "+v"(tid_l));
    const int tid = tid_l, wid = __builtin_amdgcn_readfirstlane(tid >> 6), lane = tid & 63, wr = wid >> 2, wc = wid & 3, fr = lane & 15, fq = lane >> 4;
    const int K = g.K, nt = K / BK;
    unsigned voffA[2], voffB[2];
#pragma unroll
    for (int i = 0; i < 2; ++i) { int R, C; stage_rc(tid * 16 + i * 8192, R, C); const int Rb = Epi::PERM ? ((R & ~31) + perm32(R & 31)) : R;
        voffA[i] = (unsigned)(R * K + C) * 2u; voffB[i] = (unsigned)(Rb * K + C) * 2u; }
    const size_t kstep = (size_t)(BK * 2);
    const size_t hstep = (size_t)HALF * K * 2;
    const size_t tstep = 2 * hstep;
    const unsigned ldsw = (unsigned)wid * 1024u;
    const int aoff = lds_byte(wr * 64 + fr, fq * 8), boff = lds_byte(wc * 32 + fr, fq * 8);
#define PG8_SA(b, h) (((b) * 2 + (h)) * HTB)
#define PG8_SB(b, h) ((4 + (b) * 2 + (h)) * HTB)
#define PG8_STAGE(bufoff, gbase, voff) do { _Pragma("unroll") for (int _i = 0; _i < 2; ++_i) \
        __builtin_amdgcn_global_load_lds((const unsigned*)((const char*)(gbase) + (voff)[_i]), (PG8_LAS unsigned*)(lds + (bufoff) + ldsw + _i * 8192), 16, 0, 0); } while (0)
#define PG8_LDA(dst, b, h) do { _Pragma("unroll") for (int m = 0; m < 4; ++m) _Pragma("unroll") for (int k = 0; k < 2; ++k) dst[m][k] = *(const PG8_LAS bf16x8*)(lds + PG8_SA(b, h) + aoff + m * 2048 + k * 1024); } while (0)
#define PG8_LDB(dst, b, h) do { _Pragma("unroll") for (int n = 0; n < 2; ++n) _Pragma("unroll") for (int k = 0; k < 2; ++k) dst[n][k] = *(const PG8_LAS bf16x8*)(lds + PG8_SB(b, h) + boff + n * 2048 + k * 1024); } while (0)
#define PG8_MMA(ai, bj, At, Bt) do { __builtin_amdgcn_s_setprio(1); _Pragma("unroll") for (int m = 0; m < 4; ++m) _Pragma("unroll") for (int n = 0; n < 2; ++n) _Pragma("unroll") for (int k = 0; k < 2; ++k) \
        acc[ai][bj][m][n] = __builtin_amdgcn_mfma_f32_16x16x32_bf16(Bt[n][k], At[m][k], acc[ai][bj][m][n], 0, 0, 0); __builtin_amdgcn_s_setprio(0); } while (0)
#define PG8_WAIT_V(n) asm volatile("s_waitcnt vmcnt(" #n ")" ::: "memory")
#define PG8_WAIT_L(n) asm volatile("s_waitcnt lgkmcnt(" #n ")" ::: "memory")
#define PG8_BAR __builtin_amdgcn_s_barrier()
#define PG8_SCHED __builtin_amdgcn_sched_barrier(0)
    Unit cur, nxt; int ui = 0;
    if (!S.next(0, cur)) return;
    f32x4 acc[2][2][4][2];
#pragma unroll
    for (int a = 0; a < 2; ++a)
#pragma unroll
        for (int b = 0; b < 2; ++b)
#pragma unroll
            for (int m = 0; m < 4; ++m)
#pragma unroll
                for (int n = 0; n < 2; ++n) acc[a][b][m][n] = (f32x4){0.f, 0.f, 0.f, 0.f};
    bf16x8 At[4][2], B0[2][2], B1[2][2];
    const char* cA = (const char*)g.A + (size_t)cur.pm * tstep; const char* cB = (const char*)g.Bt + (size_t)cur.pn * tstep;
    S.a_ready(cur);
    if constexpr (SP2) {
        PG8_STAGE(PG8_SB(0, 0), cB, voffB); PG8_STAGE(PG8_SB(0, 1), cB + hstep, voffB); PG8_STAGE(PG8_SA(0, 0), cA, voffA); PG8_STAGE(PG8_SA(0, 1), cA + hstep, voffA);
        if (wr == 1) PG8_BAR;
        PG8_WAIT_V(2); PG8_BAR;
        PG8_STAGE(PG8_SB(1, 0), cB + kstep, voffB); PG8_STAGE(PG8_SA(1, 0), cA + kstep, voffA); PG8_STAGE(PG8_SB(1, 1), cB + hstep + kstep, voffB);
        PG8_WAIT_V(6); PG8_BAR;
    } else {
        PG8_STAGE(PG8_SB(0, 0), cB, voffB); PG8_STAGE(PG8_SA(0, 0), cA, voffA); PG8_STAGE(PG8_SB(0, 1), cB + hstep, voffB); PG8_STAGE(PG8_SA(0, 1), cA + hstep, voffA);
        if (wr == 1) PG8_BAR;
        PG8_WAIT_V(4); PG8_BAR;
        PG8_STAGE(PG8_SB(1, 0), cB + kstep, voffB); PG8_STAGE(PG8_SA(1, 0), cA + kstep, voffA); PG8_STAGE(PG8_SB(1, 1), cB + hstep + kstep, voffB);
        PG8_WAIT_V(6); PG8_BAR;
    }
    for (;;) {
        const bool has_next = S.next(ui + 1, nxt);
        const char* nA = has_next ? (const char*)g.A + (size_t)nxt.pm * tstep : cA; const char* nB = has_next ? (const char*)g.Bt + (size_t)nxt.pn * tstep : cB;
        for (int t = 0; t < nt; t += 2) {
            const bool last = (t == nt - 2);
            const char* a1 = cA + (size_t)(t + 1) * kstep;
            const char* a2 = last ? nA : cA + (size_t)(t + 2) * kstep; const char* b2 = last ? nB : cB + (size_t)(t + 2) * kstep;
            const char* a3 = a2 + kstep; const char* b3 = b2 + kstep;
            if (last && has_next) S.a_ready(nxt);
            if constexpr (SP2) {
            PG8_LDB(B0, 0, 0); PG8_LDB(B1, 0, 1); PG8_SCHED; PG8_LDA(At, 0, 0); PG8_STAGE(PG8_SA(1, 1), a1 + hstep, voffA);
            PG8_WAIT_V(8); PG8_WAIT_L(0); PG8_BAR; PG8_MMA(0, 0, At, B0); PG8_MMA(0, 1, At, B1); PG8_BAR; PG8_SCHED;
            PG8_LDA(At, 0, 1); PG8_STAGE(PG8_SB(0, 0), b2, voffB); PG8_STAGE(PG8_SB(0, 1), b2 + hstep, voffB); PG8_STAGE(PG8_SA(0, 0), a2, voffA);
            PG8_WAIT_V(8); PG8_WAIT_L(0); PG8_BAR; PG8_MMA(1, 0, At, B0); PG8_MMA(1, 1, At, B1); PG8_BAR; PG8_SCHED;
            PG8_LDB(B0, 1, 0); PG8_LDB(B1, 1, 1); PG8_SCHED; PG8_LDA(At, 1, 0); PG8_STAGE(PG8_SA(0, 1), a2 + hstep, voffA);
            PG8_WAIT_V(8); PG8_WAIT_L(0); PG8_BAR; PG8_MMA(0, 0, At, B0); PG8_MMA(0, 1, At, B1); PG8_BAR; PG8_SCHED;
            PG8_LDA(At, 1, 1); PG8_STAGE(PG8_SB(1, 0), b3, voffB); PG8_STAGE(PG8_SB(1, 1), b3 + hstep, voffB); PG8_STAGE(PG8_SA(1, 0), a3, voffA);
            PG8_WAIT_V(8); PG8_WAIT_L(0); PG8_BAR; PG8_MMA(1, 0, At, B0); PG8_MMA(1, 1, At, B1); PG8_BAR; PG8_SCHED;
            } else {
            PG8_LDB(B0, 0, 0); PG8_SCHED; PG8_LDA(At, 0, 0); PG8_STAGE(PG8_SA(1, 1), a1 + hstep, voffA);
            PG8_WAIT_L(8); PG8_BAR; PG8_WAIT_L(0); PG8_MMA(0, 0, At, B0); PG8_BAR; PG8_SCHED;
            PG8_LDB(B1, 0, 1); PG8_STAGE(PG8_SB(0, 0), b2, voffB);
            PG8_BAR; PG8_WAIT_L(0); PG8_MMA(0, 1, At, B1); PG8_BAR;
            PG8_LDA(At, 0, 1); PG8_STAGE(PG8_SA(0, 0), a2, voffA);
            PG8_BAR; PG8_WAIT_L(0); PG8_MMA(1, 0, At, B0); PG8_BAR; PG8_SCHED;
            PG8_STAGE(PG8_SB(0, 1), b2 + hstep, voffB);
            PG8_WAIT_V(6); PG8_BAR; PG8_MMA(1, 1, At, B1); PG8_BAR;
            PG8_LDB(B0, 1, 0); PG8_SCHED; PG8_LDA(At, 1, 0); PG8_STAGE(PG8_SA(0, 1), a2 + hstep, voffA);
            PG8_WAIT_L(8); PG8_BAR; PG8_WAIT_L(0); PG8_MMA(0, 0, At, B0); PG8_BAR; PG8_SCHED;
            PG8_LDB(B1, 1, 1); PG8_STAGE(PG8_SB(1, 0), b3, voffB);
            PG8_BAR; PG8_WAIT_L(0); PG8_MMA(0, 1, At, B1); PG8_BAR;
            PG8_LDA(At, 1, 1); PG8_STAGE(PG8_SA(1, 0), a3, voffA);
            PG8_BAR; PG8_WAIT_L(0); PG8_MMA(1, 0, At, B0); PG8_BAR; PG8_SCHED;
            PG8_STAGE(PG8_SB(1, 1), b3 + hstep, voffB);
            PG8_WAIT_V(6); PG8_BAR; PG8_MMA(1, 1, At, B1); PG8_BAR;
            }
        }
        if constexpr (ALIGN_EPI) { if (wr == 0) PG8_BAR; }
        if constexpr (!Epi::AFTER_DRAIN) { E(acc, cur, wr, wc, fr, fq); S.done(cur); }
        if (!has_next) break;
#pragma unroll
        for (int a = 0; a < 2; ++a)
#pragma unroll
            for (int b = 0; b < 2; ++b)
#pragma unroll
                for (int m = 0; m < 4; ++m)
#pragma unroll
                    for (int n = 0; n < 2; ++n) acc[a][b][m][n] = (f32x4){0.f, 0.f, 0.f, 0.f};
        cur = nxt; cA = nA; cB = nB; ++ui;
        if constexpr (ALIGN_EPI) { if (wr == 1) PG8_BAR; }
    }
    PG8_WAIT_V(0);
    if constexpr (!ALIGN_EPI) { if (wr == 0) PG8_BAR; }
    PG8_BAR;
    if constexpr (Epi::AFTER_DRAIN) { E.fused(acc, cur, wr, wc, fr, fq, lds, wid, lane); S.done(cur); }
#undef PG8_SA
#undef PG8_SB
#undef PG8_STAGE
#undef PG8_LDA
#undef PG8_LDB
#undef PG8_MMA
#undef PG8_WAIT_V
#undef PG8_WAIT_L
#undef PG8_BAR
#undef PG8_SCHED
}
}

constexpr int NB = 8, SEQ = 4096, DM = 1024, M = NB * SEQ, NIN = 6144, DFF = 2816, NFI = 2 * DFF, NL = 2, CH = 128, NITEM = M / CH;
constexpr size_t MiB = 1u << 20;
constexpr size_t WS_RSS = 0, RSS_BYTES = 5 * (size_t)M * 4;
constexpr size_t WS_WIN = 2 * MiB, WS_WOUT = 26 * MiB, WS_WFI = 30 * MiB, WS_WFO = 52 * MiB, WS_WG = 63 * MiB, WS_WSB = 65 * MiB, WS_AGG = 66 * MiB;
constexpr size_t WS_XB = 72 * MiB, WS_MG = 136 * MiB, WS_Z = 200 * MiB, WS_END = 456 * MiB;
#define LAS __attribute__((address_space(3)))
typedef unsigned short bf16;
typedef unsigned v4u __attribute__((ext_vector_type(4)));
typedef float f32x4 __attribute__((ext_vector_type(4)));
typedef float f32x16 __attribute__((ext_vector_type(16)));
typedef short bf16x8 __attribute__((ext_vector_type(8)));
__device__ __forceinline__ unsigned f2bf(float f) { unsigned u = __builtin_bit_cast(unsigned, f); return (u + 0x7fffu + ((u >> 16) & 1u)) >> 16; }
__device__ __forceinline__ unsigned pk2(float lo, float hi) { return f2bf(lo) | (f2bf(hi) << 16); }
__device__ __forceinline__ float bf2f(unsigned short h) { return __builtin_bit_cast(float, (unsigned)h << 16); }
__device__ __forceinline__ float bflo(unsigned w) { return __builtin_bit_cast(float, w << 16); }
__device__ __forceinline__ float bfhi(unsigned w) { return __builtin_bit_cast(float, w & 0xffff0000u); }
__device__ __forceinline__ float wave_sum(float v) {
#pragma unroll
    for (int o = 1; o < 64; o <<= 1) v += __shfl_xor(v, o);
    return v;
}
using pg8::sigm; using pg8::gelu_t;

constexpr int XS = 136;
constexpr int L_XC = 0, L_VT = 34816, L_HB = 69632, L_MB = 104448, L_EX = 139264, L_ST = 143360, L_CY = 144384, LDS_BYTES = 153600;

__device__ __forceinline__ void transpose_item(const float* W, int ldw, int srccol0, const float* gain, int k0, bf16* WT, int ldt, int dstrow0, LAS float* scr, int lane) {
#pragma unroll 8
    for (int i = 0; i < 32; ++i) { const int kk = 2 * i + (lane >> 5); float v = W[(size_t)(k0 + kk) * ldw + srccol0 + (lane & 31)]; if (gain) v *= gain[k0 + kk]; scr[kk * 33 + (lane & 31)] = v; }
    asm volatile("s_waitcnt lgkmcnt(0)" ::: "memory");
    const int c = lane & 7;
#pragma unroll
    for (int j = 0; j < 4; ++j) { const int n = (lane >> 3) + 8 * j; const LAS float* s = scr + (8 * c) * 33 + n;
        v4u o; o.x = pk2(s[0 * 33], s[1 * 33]); o.y = pk2(s[2 * 33], s[3 * 33]); o.z = pk2(s[4 * 33], s[5 * 33]); o.w = pk2(s[6 * 33], s[7 * 33]);
        *(v4u*)(WT + (size_t)(dstrow0 + n) * ldt + k0 + 8 * c) = o; }
    asm volatile("s_waitcnt lgkmcnt(0)" ::: "memory");
}
struct Ptrs {
    const float* in[19]; float* out; unsigned char* ws; unsigned long long pad;
};
__device__ __forceinline__ void prologue(const Ptrs& P, LAS unsigned char* lds, int tid, int lane, int wave) {
    LAS float* scr = (LAS float*)(lds + wave * 16384);
    const int gw = blockIdx.x * 8 + wave, NGW = gridDim.x * 8;
    constexpr int I_IN = 16 * 192, I_OUT = 16 * 32, I_FI = 16 * 176, I_FO = 44 * 32, I_G = 32 * 8, I_L = I_IN + I_OUT + I_FI + I_FO + I_G;
    for (int it = gw; it < NL * I_L; it += NGW) {
        const int l = it / I_L; int r = it % I_L;
        if (r < I_IN) {
            const int kb = r / 192, nb = r % 192, n0 = 32 * nb, j = n0 >> 8, i = n0 & 255; int src;
            if (j < 8) src = ((i >> 7) ? 4096 : 0) + 128 * j + (i & 127);
            else if (j < 12) src = 1024 + 256 * (j - 8) + i;
            else if (j < 16) src = 2048 + 256 * (j - 12) + i;
            else src = ((i >> 7) ? 5120 : 3072) + 128 * (j - 16) + (i & 127);
            transpose_item(P.in[2] + (size_t)l * DM * NIN, NIN, src, P.in[1] + l * DM, 64 * kb, (bf16*)(P.ws + WS_WIN) + (size_t)l * NIN * DM, DM, n0, scr, lane); continue; }
        r -= I_IN;
        if (r < I_OUT) { const int kb = r / 32, nb = r % 32;
            transpose_item(P.in[14] + (size_t)l * DM * DM, DM, 32 * nb, nullptr, 64 * kb, (bf16*)(P.ws + WS_WOUT) + (size_t)l * DM * DM, DM, 32 * nb, scr, lane); continue; }
        r -= I_OUT;
        if (r < I_FI) { const int kb = r / 176, nb = r % 176, n0 = 32 * nb, j = n0 >> 8, i = n0 & 255; const int src = (i >> 7) * DFF + 128 * j + (i & 127);
            transpose_item(P.in[16] + (size_t)l * DM * NFI, NFI, src, P.in[15] + l * DM, 64 * kb, (bf16*)(P.ws + WS_WFI) + (size_t)l * NFI * DM, DM, n0, scr, lane); continue; }
        r -= I_FI;
        if (r < I_FO) { const int kb = r / 32, nb = r % 32;
            transpose_item(P.in[17] + (size_t)l * DFF * DM, DM, 32 * nb, nullptr, 64 * kb, (bf16*)(P.ws + WS_WFO) + (size_t)l * DM * DFF, DFF, 32 * nb, scr, lane); continue; }
        r -= I_FO;
        {
            const int mi = r / 8, sub = r % 8, kb = sub / 4, nb = sub % 4, gate = mi & 1, h = (mi >> 1) & 7, d = mi >> 4;
            const float* src = (gate ? P.in[11] : P.in[9]) + ((size_t)((l * 2 + d) * 8 + h)) * CH * CH;
            transpose_item(src, CH, 32 * nb, nullptr, 64 * kb, (bf16*)(P.ws + WS_WG) + ((size_t)(l * 8 + h) * 512 + (d * 2 + gate) * 128) * CH, CH, 32 * nb, scr, lane);
        }
    }
    { const float* src = P.in[5]; bf16* dst = (bf16*)(P.ws + WS_WSB); const int n4 = NL * 8 * CH * CH / 4;
      for (int i = blockIdx.x * 512 + tid; i < n4; i += gridDim.x * 512) { const f32x4 v = *(const f32x4*)(src + 4 * (size_t)i); *(unsigned long long*)(dst + 4 * (size_t)i) = (unsigned long long)pk2(v.x, v.y) | ((unsigned long long)pk2(v.z, v.w) << 32); } }
    { const float* x = P.in[0]; bf16* xb = (bf16*)(P.ws + WS_XB); float* rss = (float*)(P.ws + WS_RSS);
      for (int m = gw; m < M; m += NGW) { const f32x4* xr = (const f32x4*)(x + (size_t)m * DM) + lane; unsigned long long* o8 = (unsigned long long*)(xb + (size_t)m * DM) + lane; float s = 0.f;
#pragma unroll
          for (int j = 0; j < 4; ++j) { const f32x4 v = xr[64 * j]; s += (v.x * v.x + v.y * v.y) + (v.z * v.z + v.w * v.w); o8[64 * j] = (unsigned long long)pk2(v.x, v.y) | ((unsigned long long)pk2(v.z, v.w) << 32); }
          s = wave_sum(s); if (lane == 0) rss[m] = s; } }
}
struct MixP {
    const bf16* Z; bf16* MG; float* AGG; const bf16* WG; const bf16* WS;
    const float *lng, *lnb, *bs, *cw, *cb, *br, *bi, *lam;
};
template <int DIR> __device__ __forceinline__ void scan_a(const float (&a)[2][16], const float (&b)[2][16], int hw, float (&Pin)[8], float (&Hin)[8], float& Pt, float& Ht) {
    float Ar[8], Br[8];
#pragma unroll
    for (int k = 0; k < 8; ++k) { const int mb = k >> 2, q = (k & 3) * 4;
        const float a0 = a[mb][q], a1 = a[mb][q + 1], a2 = a[mb][q + 2], a3 = a[mb][q + 3], b0 = b[mb][q], b1 = b[mb][q + 1], b2 = b[mb][q + 2], b3 = b[mb][q + 3];
        Ar[k] = (a0 * a1) * (a2 * a3);
        Br[k] = DIR == 0 ? ((b0 * a1 + b1) * a2 + b2) * a3 + b3 : ((b3 * a2 + b2) * a1 + b1) * a0 + b0; }
    float P = 1.f, H = 0.f; const bool ownFirst = DIR == 0 ? (hw == 0) : (hw == 1);
#pragma unroll
    for (int kk = 0; kk < 8; ++kk) { const int k = DIR == 0 ? kk : 7 - kk;
        const float pA = __shfl_xor(Ar[k], 32), pB = __shfl_xor(Br[k], 32);
        const float fA = ownFirst ? Ar[k] : pA, fB = ownFirst ? Br[k] : pB, sA = ownFirst ? pA : Ar[k], sB = ownFirst ? pB : Br[k];
        const float P1 = P * fA, H1 = H * fA + fB;
        Pin[k] = ownFirst ? P : P1; Hin[k] = ownFirst ? H : H1;
        P = P1 * sA; H = H1 * sA + sB; }
    Pt = P; Ht = H;
}
template <int DIR> __device__ __forceinline__ void scan_b(const float (&a)[2][16], const float (&b)[2][16], const float (&Pin)[8], const float (&Hin)[8], float C, float (&h)[2][16]) {
#pragma unroll
    for (int k = 0; k < 8; ++k) { const int mb = k >> 2, q = (k & 3) * 4; const float cin = Pin[k] * C + Hin[k];
        if (DIR == 0) { const float h0 = a[mb][q] * cin + b[mb][q], h1 = a[mb][q + 1] * h0 + b[mb][q + 1], h2 = a[mb][q + 2] * h1 + b[mb][q + 2], h3 = a[mb][q + 3] * h2 + b[mb][q + 3];
            h[mb][q] = h0; h[mb][q + 1] = h1; h[mb][q + 2] = h2; h[mb][q + 3] = h3; }
        else { const float h3 = a[mb][q + 3] * cin + b[mb][q + 3], h2 = a[mb][q + 2] * h3 + b[mb][q + 2], h1 = a[mb][q + 1] * h2 + b[mb][q + 1], h0 = a[mb][q] * h1 + b[mb][q];
            h[mb][q] = h0; h[mb][q + 1] = h1; h[mb][q + 2] = h2; h[mb][q + 3] = h3; } }
}
__device__ __forceinline__ void gates_dir(LAS unsigned char* lds, const MixP& X, int h, int d, int cb, int th, int lane, float (&a)[2][16], float (&bt)[2][16]) {
    const int l31 = lane & 31, hw = lane >> 5;
    f32x16 ar[2], ai[2];
#pragma unroll
    for (int mb = 0; mb < 2; ++mb)
#pragma unroll
        for (int r = 0; r < 16; ++r) { ar[mb][r] = 0.f; ai[mb][r] = 0.f; }
    const bf16* wr_ = X.WG + ((size_t)h * 512 + d * 256 + 32 * cb + l31) * CH + 8 * hw;
    const bf16* wi_ = wr_ + 128 * CH;
    const LAS bf16* xa = (const LAS bf16*)(lds + L_XC) + (64 * th + l31) * XS + 8 * hw;
#pragma unroll
    for (int ks = 0; ks < 8; ++ks) {
        const bf16x8 br = *(const bf16x8*)(wr_ + 16 * ks), bi = *(const bf16x8*)(wi_ + 16 * ks);
#pragma unroll
        for (int mb = 0; mb < 2; ++mb) { const bf16x8 af = *(const LAS bf16x8*)(xa + 32 * mb * XS + 16 * ks);
            ar[mb] = __builtin_amdgcn_mfma_f32_32x32x16_bf16(af, br, ar[mb], 0, 0, 0); ai[mb] = __builtin_amdgcn_mfma_f32_32x32x16_bf16(af, bi, ai[mb], 0, 0, 0); }
    }
    const int ch = h * CH + 32 * cb + l31;
    const float brv = X.br[d * DM + ch], biv = X.bi[d * DM + ch], lam = X.lam[d * DM + ch];
    const float sp8 = 8.0f * log1pf(__expf(-lam));
    const LAS bf16* xcol = (const LAS bf16*)(lds + L_XC) + (64 * th + 4 * hw) * XS + 32 * cb + l31;
#pragma unroll
    for (int mb = 0; mb < 2; ++mb)
#pragma unroll
        for (int r = 0; r < 16; ++r) { const int tw = 32 * mb + 8 * (r >> 2) + (r & 3);
            const float xv = bf2f(xcol[tw * XS]);
            const float rg = sigm(ar[mb][r] + brv), ig = sigm(ai[mb][r] + biv), la = -sp8 * rg;
            const float av = __expf(la), mult = __builtin_sqrtf(fmaxf(1.0f - av * av, 0.f));
            a[mb][r] = av; bt[mb][r] = mult * (ig * xv); }
}
template <int PASS> __device__ __forceinline__ void mixer_phase(LAS unsigned char* lds, const MixP& X, int tid, int lane, int wave) {
    const int cb = wave & 3, th = wave >> 2, l31 = lane & 31, hw = lane >> 5;
    LAS float* EX = (LAS float*)(lds + L_EX);
    LAS float* ST = (LAS float*)(lds + L_ST);
    LAS float* CY = (LAS float*)(lds + L_CY);
    for (int item = blockIdx.x; item < NITEM; item += gridDim.x) {
        const int n = item & 31; const size_t row0 = (size_t)item * CH;
        if (PASS == 2) {
            for (int i = 0; i < 16; ++i) { const int tok = wave * 16 + i; const bf16* vr = X.Z + (row0 + tok) * 4096 + 1024 + 8 * lane;
                const v4u w0 = *(const v4u*)vr, w1 = *(const v4u*)(vr + 512); float v[16];
                v[0] = bflo(w0.x); v[1] = bfhi(w0.x); v[2] = bflo(w0.y); v[3] = bfhi(w0.y); v[4] = bflo(w0.z); v[5] = bfhi(w0.z); v[6] = bflo(w0.w); v[7] = bfhi(w0.w);
                v[8] = bflo(w1.x); v[9] = bfhi(w1.x); v[10] = bflo(w1.y); v[11] = bfhi(w1.y); v[12] = bflo(w1.z); v[13] = bfhi(w1.z); v[14] = bflo(w1.w); v[15] = bfhi(w1.w);
                float s = 0.f;
#pragma unroll
                for (int j = 0; j < 16; ++j) s += v[j];
                const float mean = wave_sum(s) * (1.0f / 1024.0f); float q = 0.f;
#pragma unroll
                for (int j = 0; j < 16; ++j) { const float dd = v[j] - mean; q += dd * dd; }
                const float rstd = __builtin_amdgcn_rsqf(wave_sum(q) * (1.0f / 1024.0f) + 1e-6f);
                if (lane == 0) { ST[2 * tok] = mean; ST[2 * tok + 1] = rstd; } }
            for (int e = tid; e < 2048; e += 512) { const int d = e >> 10, ch = e & 1023; float c = 0.f;
                if (d == 0) { for (int m2 = 0; m2 < n; ++m2) { const float* ag = X.AGG + ((size_t)(item - n + m2) * 2 + 0) * 2048; c = ag[ch] * c + ag[1024 + ch]; } }
                else { for (int m2 = 31; m2 > n; --m2) { const float* ag = X.AGG + ((size_t)(item - n + m2) * 2 + 1) * 2048; c = ag[ch] * c + ag[1024 + ch]; } }
                CY[e] = c; }
            __syncthreads();
        }
        for (int h = 0; h < 8; ++h) {
            { const int c8 = tid & 15, chn = h * CH + 8 * c8; float w[4][8], cbv[8];
#pragma unroll
              for (int j = 0; j < 8; ++j) { cbv[j] = X.cb[chn + j];
#pragma unroll
                  for (int k = 0; k < 4; ++k) w[k][j] = X.cw[k * DM + chn + j]; }
#pragma unroll
              for (int i = 0; i < 4; ++i) { const int tok = (tid >> 4) + 32 * i, tp = n * CH + tok; float o[8];
#pragma unroll
                  for (int j = 0; j < 8; ++j) o[j] = cbv[j];
#pragma unroll
                  for (int k = 0; k < 4; ++k) { const int t2 = tp + k - 1;
                      if (t2 >= 0 && t2 < SEQ) { const v4u zz = *(const v4u*)(X.Z + (row0 + tok + k - 1) * 4096 + 2048 + chn);
                          o[0] += w[k][0] * bflo(zz.x); o[1] += w[k][1] * bfhi(zz.x); o[2] += w[k][2] * bflo(zz.y); o[3] += w[k][3] * bfhi(zz.y);
                          o[4] += w[k][4] * bflo(zz.z); o[5] += w[k][5] * bfhi(zz.z); o[6] += w[k][6] * bflo(zz.w); o[7] += w[k][7] * bfhi(zz.w); } }
                  v4u ov; ov.x = pk2(o[0], o[1]); ov.y = pk2(o[2], o[3]); ov.z = pk2(o[4], o[5]); ov.w = pk2(o[6], o[7]);
                  *(LAS v4u*)((LAS bf16*)(lds + L_XC) + tok * XS + 8 * c8) = ov; }
              if (PASS == 2) { float g[8], bb[8];
#pragma unroll
                  for (int j = 0; j < 8; ++j) { g[j] = X.lng[chn + j]; bb[j] = X.lnb[chn + j]; }
#pragma unroll
                  for (int i = 0; i < 4; ++i) { const int tok = (tid >> 4) + 32 * i; const v4u zz = *(const v4u*)(X.Z + (row0 + tok) * 4096 + 1024 + chn);
                      const float mean = ST[2 * tok], rstd = ST[2 * tok + 1]; float v[8];
                      v[0] = bflo(zz.x); v[1] = bfhi(zz.x); v[2] = bflo(zz.y); v[3] = bfhi(zz.y); v[4] = bflo(zz.z); v[5] = bfhi(zz.z); v[6] = bflo(zz.w); v[7] = bfhi(zz.w);
                      LAS bf16* vt = (LAS bf16*)(lds + L_VT) + (8 * c8) * XS + tok;
#pragma unroll
                      for (int j = 0; j < 8; ++j) vt[j * XS] = (bf16)f2bf((v[j] - mean) * rstd * g[j] + bb[j]); } }
            }
            __syncthreads();
            LAS bf16* hb = (LAS bf16*)(lds + L_HB) + (64 * th + 4 * hw) * XS + 32 * cb + l31;
            if (PASS == 2) {
                f32x16 am[2];
#pragma unroll
                for (int mb = 0; mb < 2; ++mb)
#pragma unroll
                    for (int r = 0; r < 16; ++r) am[mb][r] = 0.f;
                const bf16* wa = X.WS + ((size_t)h * CH + 64 * th + l31) * CH + 8 * hw;
                const LAS bf16* vb = (const LAS bf16*)(lds + L_VT) + (32 * cb + l31) * XS + 8 * hw;
#pragma unroll
                for (int ks = 0; ks < 8; ++ks) { const bf16x8 bf = *(const LAS bf16x8*)(vb + 16 * ks);
#pragma unroll
                    for (int mb = 0; mb < 2; ++mb) { const bf16x8 af = *(const bf16x8*)(wa + 32 * mb * CH + 16 * ks); am[mb] = __builtin_amdgcn_mfma_f32_32x32x16_bf16(af, bf, am[mb], 0, 0, 0); } }
                LAS bf16* mbp = (LAS bf16*)(lds + L_MB) + (64 * th + 4 * hw) * XS + 32 * cb + l31;
                const float* bsp = X.bs + h * CH + 64 * th + 4 * hw;
#pragma unroll
                for (int mb = 0; mb < 2; ++mb)
#pragma unroll
                    for (int r = 0; r < 16; ++r) { const int tw = 32 * mb + 8 * (r >> 2) + (r & 3); mbp[tw * XS] = (bf16)f2bf(am[mb][r] + bsp[tw]); }
            }
            {
                float a[2][16], bt[2][16], Pin[8], Hin[8], Pt, Ht;
                gates_dir(lds, X, h, 0, cb, th, lane, a, bt);
                scan_a<0>(a, bt, hw, Pin, Hin, Pt, Ht);
                if (hw == 0) { EX[((0 * 8 + wave) * 32 + l31) * 2] = Pt; EX[((0 * 8 + wave) * 32 + l31) * 2 + 1] = Ht; }
                if (PASS == 2) {
                    __syncthreads();
                    float C = CY[h * CH + 32 * cb + l31];
                    if (th == 1) { const float A0 = EX[((0 * 8 + cb) * 32 + l31) * 2], B0 = EX[((0 * 8 + cb) * 32 + l31) * 2 + 1]; C = A0 * C + B0; }
                    float hs[2][16];
                    scan_b<0>(a, bt, Pin, Hin, C, hs);
#pragma unroll
                    for (int mb = 0; mb < 2; ++mb)
#pragma unroll
                        for (int r = 0; r < 16; ++r) { const int tw = 32 * mb + 8 * (r >> 2) + (r & 3); hb[tw * XS] = (bf16)f2bf(hs[mb][r]); }
                }
            }
            {
                float a[2][16], bt[2][16], Pin[8], Hin[8], Pt, Ht;
                gates_dir(lds, X, h, 1, cb, th, lane, a, bt);
                scan_a<1>(a, bt, hw, Pin, Hin, Pt, Ht);
                if (hw == 0) { EX[((1 * 8 + wave) * 32 + l31) * 2] = Pt; EX[((1 * 8 + wave) * 32 + l31) * 2 + 1] = Ht; }
                __syncthreads();
                if (PASS == 2) {
                    float C = CY[1024 + h * CH + 32 * cb + l31];
                    if (th == 0) { const float A1 = EX[((1 * 8 + 4 + cb) * 32 + l31) * 2], B1 = EX[((1 * 8 + 4 + cb) * 32 + l31) * 2 + 1]; C = A1 * C + B1; }
                    float hs[2][16];
                    scan_b<1>(a, bt, Pin, Hin, C, hs);
#pragma unroll
                    for (int mb = 0; mb < 2; ++mb)
#pragma unroll
                        for (int r = 0; r < 16; ++r) { const int tw = 32 * mb + 8 * (r >> 2) + (r & 3); hb[tw * XS] = (bf16)f2bf(hs[mb][r] + bf2f(hb[tw * XS])); }
                }
            }
            if (PASS == 1) {
                if (tid < 256) { const int d = tid >> 7, c = tid & 127, cbb = c >> 5, cl = c & 31;
                    const float A0 = EX[((d * 8 + cbb) * 32 + cl) * 2], B0 = EX[((d * 8 + cbb) * 32 + cl) * 2 + 1], A1 = EX[((d * 8 + 4 + cbb) * 32 + cl) * 2], B1 = EX[((d * 8 + 4 + cbb) * 32 + cl) * 2 + 1];
                    float* ag = X.AGG + ((size_t)item * 2 + d) * 2048 + h * CH + c;
                    ag[0] = A0 * A1; ag[1024] = d == 0 ? (B0 * A1 + B1) : (B1 * A0 + B0); }
            } else {
                __syncthreads();
                { const int c8 = tid & 15, chn = h * CH + 8 * c8;
#pragma unroll
                  for (int i = 0; i < 4; ++i) { const int tok = (tid >> 4) + 32 * i; const bf16* zr = X.Z + (row0 + tok) * 4096 + chn;
                      const v4u pa = *(const v4u*)zr, qb = *(const v4u*)(zr + 3072);
                      const v4u hv = *(const LAS v4u*)((const LAS bf16*)(lds + L_HB) + tok * XS + 8 * c8), mv = *(const LAS v4u*)((const LAS bf16*)(lds + L_MB) + tok * XS + 8 * c8);
                      v4u o;
                      o.x = pk2(bflo(pa.x) * bflo(mv.x) + bflo(qb.x) * bflo(hv.x), bfhi(pa.x) * bfhi(mv.x) + bfhi(qb.x) * bfhi(hv.x));
                      o.y = pk2(bflo(pa.y) * bflo(mv.y) + bflo(qb.y) * bflo(hv.y), bfhi(pa.y) * bfhi(mv.y) + bfhi(qb.y) * bfhi(hv.y));
                      o.z = pk2(bflo(pa.z) * bflo(mv.z) + bflo(qb.z) * bflo(hv.z), bfhi(pa.z) * bfhi(mv.z) + bfhi(qb.z) * bfhi(hv.z));
                      o.w = pk2(bflo(pa.w) * bflo(mv.w) + bflo(qb.w) * bflo(hv.w), bfhi(pa.w) * bfhi(mv.w) + bfhi(qb.w) * bfhi(hv.w));
                      *(v4u*)(X.MG + (row0 + tok) * 1024 + chn) = o; } }
            }
        }
        __syncthreads();
    }
}
__global__ void __launch_bounds__(512, 2) fwd_megakernel(Ptrs P) {
    extern __shared__ __attribute__((aligned(16))) unsigned char lds_raw[];
    LAS unsigned char* lds = (LAS unsigned char*)lds_raw;
    cg::grid_group grid = cg::this_grid();
    const int tid = threadIdx.x, lane = tid & 63, wave = __builtin_amdgcn_readfirstlane(tid >> 6);
    unsigned char* ws = P.ws;
    float* rss = (float*)(ws + WS_RSS);
    bf16* XB = (bf16*)(ws + WS_XB); bf16* MG = (bf16*)(ws + WS_MG); bf16* Z = (bf16*)(ws + WS_Z); bf16* FF = (bf16*)(ws + WS_Z);
    const int G = (int)gridDim.x, c = (int)blockIdx.x;

#ifndef NO_PRO
    prologue(P, lds, tid, lane, wave);
#endif
    grid.sync();
    for (int l = 0; l < NL; ++l) {
        {
            pg8::Gemm g{XB, (const bf16*)(ws + WS_WIN) + (size_t)l * NIN * DM, M, NIN, DM}; pg8::StaticOrder S; S.init(M, NIN, G, c);
            pg8::EpiIn E{Z, rss + (size_t)(2 * l) * M};
#if !defined(NO_GEMM) && !defined(NO_G1)
            pg8::gemm_phase<pg8::EpiIn, pg8::StaticOrder, true, true>(lds, g, S, E);
#endif
        }
        grid.sync();
        MixP X; X.Z = Z; X.MG = MG; X.AGG = (float*)(ws + WS_AGG); X.WG = (const bf16*)(ws + WS_WG) + (size_t)l * 8 * 512 * CH; X.WS = (const bf16*)(ws + WS_WSB) + (size_t)l * 8 * CH * CH;
        X.lng = P.in[3] + l * DM; X.lnb = P.in[4] + l * DM; X.bs = P.in[6] + l * 8 * CH; X.cw = P.in[7] + l * 4 * DM; X.cb = P.in[8] + l * DM;
        X.br = P.in[10] + l * 2 * DM; X.bi = P.in[12] + l * 2 * DM; X.lam = P.in[13] + l * 2 * DM;
#ifndef NO_M1
        { int t_ = threadIdx.x; asm volatile("" : "+v"(t_)); mixer_phase<1>(lds, X, t_, t_ & 63, __builtin_amdgcn_readfirstlane(t_ >> 6)); }
#endif
        grid.sync();
#ifndef NO_M2
        { int t_ = threadIdx.x; asm volatile("" : "+v"(t_)); mixer_phase<2>(lds, X, t_, t_ & 63, __builtin_amdgcn_readfirstlane(t_ >> 6)); }
#endif
        grid.sync();
        {
            pg8::Gemm g{MG, (const bf16*)(ws + WS_WOUT) + (size_t)l * DM * DM, M, DM, DM}; pg8::StaticOrder S; S.init(M, DM, G, c);
            pg8::EpiRes E{l == 0 ? P.in[0] : (const float*)P.out, P.out, XB, rss + (size_t)(2 * l + 1) * M};
#if !defined(NO_GEMM) && !defined(NO_G2)
            pg8::gemm_phase<pg8::EpiRes, pg8::StaticOrder, true, true>(lds, g, S, E);
#endif
        }
        grid.sync();
        {
            pg8::Gemm g{XB, (const bf16*)(ws + WS_WFI) + (size_t)l * NFI * DM, M, NFI, DM}; pg8::StaticOrder S; S.init(M, NFI, G, c);
            pg8::EpiFfn E{FF, rss + (size_t)(2 * l + 1) * M};
#if !defined(NO_GEMM) && !defined(NO_G3)
            pg8::gemm_phase<pg8::EpiFfn, pg8::StaticOrder, true, true>(lds, g, S, E);
#endif
        }
        grid.sync();
        {
            pg8::Gemm g{FF, (const bf16*)(ws + WS_WFO) + (size_t)l * DM * DFF, M, DM, DFF}; pg8::StaticOrder S; S.init(M, DM, G, c);
            pg8::EpiRes E{(const float*)P.out, P.out, XB, rss + (size_t)(2 * l + 2) * M};
#if !defined(NO_GEMM) && !defined(NO_G4)
            pg8::gemm_phase<pg8::EpiRes, pg8::StaticOrder, true, true>(lds, g, S, E);
#endif
        }
        grid.sync();
    }
    { const float* fg = P.in[18]; const float* r4 = rss + (size_t)4 * M; const int gw = c * 8 + wave, NGW = G * 8;
      f32x4 gv[4];
#pragma unroll
      for (int j = 0; j < 4; ++j) gv[j] = *((const f32x4*)fg + lane + 64 * j);
      for (int m = gw; m < M; m += NGW) { f32x4* xr = (f32x4*)(P.out + (size_t)m * DM) + lane; const float s = __builtin_amdgcn_rsqf(r4[m] * (1.0f / 1024.0f) + 1e-6f);
#pragma unroll
          for (int j = 0; j < 4; ++j) { f32x4 v = xr[64 * j]; v = v * s * gv[j]; xr[64 * j] = v; } } }
}

extern "C" void kernel_launch(void* const* d_in, const int* in_sizes, int n_in, void* d_out, int out_size, void* d_ws, size_t ws_size, hipStream_t stream) {
    static int grid = 0;
    if (grid == 0) {
        if (n_in != 19 || in_sizes[0] != M * DM || out_size != M * DM || ws_size < WS_END) { fprintf(stderr, "kernel_launch: unexpected shapes / workspace (n_in %d, ws %zu)\n", n_in, ws_size); grid = -1; return; }
        int dev = 0, cus = 0, per_cu = 0;
        hipGetDevice(&dev); hipDeviceGetAttribute(&cus, hipDeviceAttributeMultiprocessorCount, dev);
        hipFuncSetAttribute((const void*)fwd_megakernel, hipFuncAttributeMaxDynamicSharedMemorySize, LDS_BYTES);
        hipOccupancyMaxActiveBlocksPerMultiprocessor(&per_cu, (const void*)fwd_megakernel, 512, LDS_BYTES);
        if (per_cu < 1) { fprintf(stderr, "kernel_launch: occupancy query says %d blocks per CU\n", per_cu); per_cu = 1; }
        (void)hipGetLastError();
        grid = cus * 1;
    }
    if (grid < 0) return;
    hipMemsetAsync((char*)d_ws + WS_RSS, 0, RSS_BYTES, stream);
    Ptrs p{};
    for (int i = 0; i < 19; ++i) p.in[i] = (const float*)d_in[i];
    p.out = (float*)d_out; p.ws = (unsigned char*)d_ws; p.pad = 0;
    void* args[] = {&p};
    hipError_t e = hipLaunchCooperativeKernel((const void*)fwd_megakernel, dim3(grid), dim3(512), args, LDS_BYTES, stream);
    if (e != hipSuccess) fprintf(stderr, "cooperative launch failed: %s (grid %d)\n", hipGetErrorString(e), grid);
}
```

```cpp
#include <hip/hip_runtime.h>
#include <hip/hip_cooperative_groups.h>
#include <cstdio>
#include <cstdint>
namespace cg = cooperative_groups;

#ifndef PROBE_M1
#define PROBE_M1 1
#endif
#ifndef PROBE_M2
#define PROBE_M2 1
#endif
#ifndef PROBE_G1
#define PROBE_G1 1
#endif
#ifndef PROBE_G3
#define PROBE_G3 1
#endif
#ifndef PROBE_PRO
#define PROBE_PRO 1
#endif
#ifndef PROBE_SYNC
#define PROBE_SYNC 1
#endif
namespace pg8 {
#define PG8_LAS __attribute__((address_space(3)))
typedef unsigned short bf16_t;
typedef short bf16x8 __attribute__((ext_vector_type(8)));
typedef float f32x4 __attribute__((ext_vector_type(4)));
typedef unsigned u32x4 __attribute__((ext_vector_type(4)));
constexpr int BM = 256, BK = 64, HALF = 128, HTB = HALF * BK * 2  , STAGE_BYTES = 8 * HTB, NXCD = 8, WGM = 8;

__host__ __device__ __forceinline__ int lds_byte(int r, int c) { const int st = (r >> 4) * 2 + (c >> 5), rr = r & 15, cc = c & 31, ob = rr * 64 + cc * 2; return st * 1024 + (ob ^ (((ob >> 9) & 1) << 5)); }
__host__ __device__ __forceinline__ void stage_rc(int b, int& R, int& C) { const int st = b / 1024, sb = b % 1024, swz = sb ^ (((sb >> 9) & 1) << 5); R = (st >> 1) * 16 + swz / 64; C = (st & 1) * 32 + (swz % 64) / 2; }
__host__ __device__ __forceinline__ int perm32(int rho) { const int n = rho >> 4, i = rho & 15; return 8 * (i >> 2) + 4 * n + (i & 3); }

struct Unit { int pm, pn; };
struct Gemm { const bf16_t* A; const bf16_t* Bt; int M, N, K; };

struct StaticOrder {
    int nM, nN, nwg, G, c;
    __host__ __device__ void init(int M, int N, int G_, int c_) { nM = M / BM; nN = N / BM; nwg = nM * nN; G = G_; c = c_; }
    __host__ __device__ bool next(int i, Unit& u) const {
        const long L = (long)i * G + c; if (L >= nwg) return false;
        int wgid = (int)L; { const int q = nwg / NXCD, r = nwg % NXCD, xcd = wgid % NXCD, off = wgid / NXCD; wgid = (xcd < r ? xcd * (q + 1) : r * (q + 1) + (xcd - r) * q) + off; }
        const int nig = WGM * nN, gid = wgid / nig, fm = gid * WGM, gsz = (nM - fm) < WGM ? (nM - fm) : WGM;
        u.pm = fm + ((wgid % nig) % gsz); u.pn = (wgid % nig) / gsz; return true;
    }
    __device__ __forceinline__ void a_ready(const Unit&) const {}
    __device__ __forceinline__ void done(const Unit&) const {}
};
__device__ __forceinline__ unsigned cvt_pk_bf16(float lo, float hi) { unsigned r; asm volatile("v_cvt_pk_bf16_f32 %0, %1, %2" : "=v"(r) : "v"(lo), "v"(hi)); return r; }
typedef float f32x2 __attribute__((ext_vector_type(2)));
typedef unsigned u32x2 __attribute__((ext_vector_type(2)));
__device__ __forceinline__ float sigm(float x) { return __builtin_amdgcn_rcpf(1.0f + __expf(-x)); }
__device__ __forceinline__ float gelu_t(float x) { const float t = 1.5957691216057308f * (x + 0.044715f * x * x * x); return x * sigm(t); }
constexpr float RMS_EPS = 1e-6f;

struct EpiIn {
    static constexpr bool PERM = true, AFTER_DRAIN = false;
    bf16_t* Z; const float* rowss;
    __device__ __forceinline__ void operator()(const f32x4 (&acc)[2][2][4][2], const Unit& u, int wr, int wc, int fr, int fq) const {
        const int pn = u.pn; int type, outcol;
        if (pn < 8) { type = 0; outcol = 128 * pn; } else if (pn < 12) { type = 1; outcol = 1024 + 256 * (pn - 8); } else if (pn < 16) { type = 2; outcol = 2048 + 256 * (pn - 12); } else { type = 3; outcol = 3072 + 128 * (pn - 16); }
        const int row0 = u.pm * BM + wr * 64 + fr;
#pragma unroll
        for (int ai = 0; ai < 2; ++ai)
#pragma unroll
            for (int m = 0; m < 4; ++m) {
                const int row = row0 + ai * HALF + m * 16;
                const float s = __builtin_amdgcn_rsqf(rowss[row] * (1.0f / 1024.0f) + RMS_EPS);
                bf16_t* rowp = Z + (size_t)row * 4096 + outcol + wc * 32 + 8 * fq;
                if (type == 0 || type == 3) {
                    const f32x4 a0 = acc[ai][0][m][0] * s, a1 = acc[ai][0][m][1] * s, g0 = acc[ai][1][m][0] * s, g1 = acc[ai][1][m][1] * s;
                    float o[8];
#pragma unroll
                    for (int j = 0; j < 4; ++j) { o[j] = gelu_t(a0[j]) * sigm(g0[j]); o[4 + j] = gelu_t(a1[j]) * sigm(g1[j]); }
                    u32x4 w; w.x = cvt_pk_bf16(o[0], o[1]); w.y = cvt_pk_bf16(o[2], o[3]); w.z = cvt_pk_bf16(o[4], o[5]); w.w = cvt_pk_bf16(o[6], o[7]);
                    *(u32x4*)rowp = w;
                } else {
#pragma unroll
                    for (int bj = 0; bj < 2; ++bj) {
                        f32x4 v0 = acc[ai][bj][m][0] * s, v1 = acc[ai][bj][m][1] * s;
                        if (type == 1) {
#pragma unroll
                            for (int j = 0; j < 4; ++j) { v0[j] = gelu_t(v0[j]); v1[j] = gelu_t(v1[j]); }
                        }
                        u32x4 w; w.x = cvt_pk_bf16(v0[0], v0[1]); w.y = cvt_pk_bf16(v0[2], v0[3]); w.z = cvt_pk_bf16(v1[0], v1[1]); w.w = cvt_pk_bf16(v1[2], v1[3]);
                        *(u32x4*)(rowp + bj * HALF) = w;
                    }
                }
                asm volatile("" ::: "memory");
            }
    }
};
struct EpiFfn {
    static constexpr bool PERM = true, AFTER_DRAIN = false;
    bf16_t* F; const float* rowss;
    __device__ __forceinline__ void operator()(const f32x4 (&acc)[2][2][4][2], const Unit& u, int wr, int wc, int fr, int fq) const {
        const int row0 = u.pm * BM + wr * 64 + fr;
#pragma unroll
        for (int ai = 0; ai < 2; ++ai)
#pragma unroll
            for (int m = 0; m < 4; ++m) {
                const int row = row0 + ai * HALF + m * 16;
                const float s = __builtin_amdgcn_rsqf(rowss[row] * (1.0f / 1024.0f) + RMS_EPS);
                bf16_t* rowp = F + (size_t)row * 2816 + 128 * u.pn + wc * 32 + 8 * fq;
                const f32x4 a0 = acc[ai][0][m][0] * s, a1 = acc[ai][0][m][1] * s, g0 = acc[ai][1][m][0] * s, g1 = acc[ai][1][m][1] * s;
                float o[8];
#pragma unroll
                for (int j = 0; j < 4; ++j) { o[j] = a0[j] * sigm(a0[j]) * g0[j]; o[4 + j] = a1[j] * sigm(a1[j]) * g1[j]; }
                u32x4 w; w.x = cvt_pk_bf16(o[0], o[1]); w.y = cvt_pk_bf16(o[2], o[3]); w.z = cvt_pk_bf16(o[4], o[5]); w.w = cvt_pk_bf16(o[6], o[7]);
                *(u32x4*)rowp = w;
                asm volatile("" ::: "memory");
            }
    }
};
struct EpiRes {
    static constexpr bool PERM = false, AFTER_DRAIN = false;
    const float* base; float* out; bf16_t* xb; float* rowss;
    __device__ __forceinline__ void operator()(const f32x4 (&acc)[2][2][4][2], const Unit& u, int wr, int wc, int fr, int fq) const {
        const int row0 = u.pm * BM + wr * 64 + fr, col0 = u.pn * BM + wc * 32 + 4 * fq;
#pragma unroll
        for (int ai = 0; ai < 2; ++ai)
#pragma unroll
            for (int m = 0; m < 4; ++m) {
                const int row = row0 + ai * HALF + m * 16; const size_t off = (size_t)row * 1024 + col0; float ss = 0.f;
#pragma unroll
                for (int bj = 0; bj < 2; ++bj)
#pragma unroll
                    for (int n = 0; n < 2; ++n) {
                        const f32x4 bs = *(const f32x4*)(base + off + bj * HALF + n * 16); const f32x4 o = bs + acc[ai][bj][m][n];
                        *(f32x4*)(out + off + bj * HALF + n * 16) = o; ss += (o[0] * o[0] + o[1] * o[1]) + (o[2] * o[2] + o[3] * o[3]);
                        u32x2 w; w.x = cvt_pk_bf16(o[0], o[1]); w.y = cvt_pk_bf16(o[2], o[3]); *(u32x2*)(xb + off + bj * HALF + n * 16) = w;
                    }
                ss += __shfl_xor(ss, 16); ss += __shfl_xor(ss, 32);
                if (fq == 0) atomicAdd(rowss + row, ss);
                asm volatile("" ::: "memory");
            }
    }
};
template <class Epi, class Sched, bool ALIGN_EPI = false, bool SP2 = false>
__device__ __forceinline__ void gemm_phase(PG8_LAS unsigned char* lds, const Gemm g, const Sched& S, const Epi& E) {
    int tid_l = threadIdx.x; asm volatile("" : "+v"(tid_l));
    const int tid = tid_l, wid = __builtin_amdgcn_readfirstlane(tid >> 6), lane = tid & 63, wr = wid >> 2, wc = wid & 3, fr = lane & 15, fq = lane >> 4;
    const int K = g.K, nt = K / BK;
    unsigned voffA[2], voffB[2];
#pragma unroll
    for (int i = 0; i < 2; ++i) { int R, C; stage_rc(tid * 16 + i * 8192, R, C); const int Rb = Epi::PERM ? ((R & ~31) + perm32(R & 31)) : R;
        voffA[i] = (unsigned)(R * K + C) * 2u; voffB[i] = (unsigned)(Rb * K + C) * 2u; }
    const size_t kstep = (size_t)(BK * 2);
    const size_t hstep = (size_t)HALF * K * 2;
    const size_t tstep = 2 * hstep;
    const unsigned ldsw = (unsigned)wid * 1024u;
    const int aoff = lds_byte(wr * 64 + fr, fq * 8), boff = lds_byte(wc * 32 + fr, fq * 8);
#define PG8_SA(b, h) (((b) * 2 + (h)) * HTB)
#define PG8_SB(b, h) ((4 + (b) * 2 + (h)) * HTB)
#define PG8_STAGE(bufoff, gbase, voff) do { _Pragma("unroll") for (int _i = 0; _i < 2; ++_i) \
        __builtin_amdgcn_global_load_lds((const unsigned*)((const char*)(gbase) + (voff)[_i]), (PG8_LAS unsigned*)(lds + (bufoff) + ldsw + _i * 8192), 16, 0, 0); } while (0)
#define PG8_LDA(dst, b, h) do { _Pragma("unroll") for (int m = 0; m < 4; ++m) _Pragma("unroll") for (int k = 0; k < 2; ++k) dst[m][k] = *(const PG8_LAS bf16x8*)(lds + PG8_SA(b, h) + aoff + m * 2048 + k * 1024); } while (0)
#define PG8_LDB(dst, b, h) do { _Pragma("unroll") for (int n = 0; n < 2; ++n) _Pragma("unroll") for (int k = 0; k < 2; ++k) dst[n][k] = *(const PG8_LAS bf16x8*)(lds + PG8_SB(b, h) + boff + n * 2048 + k * 1024); } while (0)
#define PG8_MMA(ai, bj, At, Bt) do { __builtin_amdgcn_s_setprio(1); _Pragma("unroll") for (int m = 0; m < 4; ++m) _Pragma("unroll") for (int n = 0; n < 2; ++n) _Pragma("unroll") for (int k = 0; k < 2; ++k) \
        acc[ai][bj][m][n] = __builtin_amdgcn_mfma_f32_16x16x32_bf16(Bt[n][k], At[m][k], acc[ai][bj][m][n], 0, 0, 0); __builtin_amdgcn_s_setprio(0); } while (0)
#define PG8_WAIT_V(n) asm volatile("s_waitcnt vmcnt(" #n ")" ::: "memory")
#define PG8_WAIT_L(n) asm volatile("s_waitcnt lgkmcnt(" #n ")" ::: "memory")
#define PG8_BAR __builtin_amdgcn_s_barrier()
#define PG8_SCHED __builtin_amdgcn_sched_barrier(0)
    Unit cur, nxt; int ui = 0;
    if (!S.next(0, cur)) return;
    f32x4 acc[2][2][4][2];
#pragma unroll
    for (int a = 0; a < 2; ++a)
#pragma unroll
        for (int b = 0; b < 2; ++b)
#pragma unroll
            for (int m = 0; m < 4; ++m)
#pragma unroll
                for (int n = 0; n < 2; ++n) acc[a][b][m][n] = (f32x4){0.f, 0.f, 0.f, 0.f};
    bf16x8 At[4][2], B0[2][2], B1[2][2];
    const char* cA = (const char*)g.A + (size_t)cur.pm * tstep; const char* cB = (const char*)g.Bt + (size_t)cur.pn * tstep;
    S.a_ready(cur);
    if constexpr (SP2) {
        PG8_STAGE(PG8_SB(0, 0), cB, voffB); PG8_STAGE(PG8_SB(0, 1), cB + hstep, voffB); PG8_STAGE(PG8_SA(0, 0), cA, voffA); PG8_STAGE(PG8_SA(0, 1), cA + hstep, voffA);
        if (wr == 1) PG8_BAR;
        PG8_WAIT_V(2); PG8_BAR;
        PG8_STAGE(PG8_SB(1, 0), cB + kstep, voffB); PG8_STAGE(PG8_SA(1, 0), cA + kstep, voffA); PG8_STAGE(PG8_SB(1, 1), cB + hstep + kstep, voffB);
        PG8_WAIT_V(6); PG8_BAR;
    } else {
        PG8_STAGE(PG8_SB(0, 0), cB, voffB); PG8_STAGE(PG8_SA(0, 0), cA, voffA); PG8_STAGE(PG8_SB(0, 1), cB + hstep, voffB); PG8_STAGE(PG8_SA(0, 1), cA + hstep, voffA);
        if (wr == 1) PG8_BAR;
        PG8_WAIT_V(4); PG8_BAR;
        PG8_STAGE(PG8_SB(1, 0), cB + kstep, voffB); PG8_STAGE(PG8_SA(1, 0), cA + kstep, voffA); PG8_STAGE(PG8_SB(1, 1), cB + hstep + kstep, voffB);
        PG8_WAIT_V(6); PG8_BAR;
    }
    for (;;) {
        const bool has_next = S.next(ui + 1, nxt);
        const char* nA = has_next ? (const char*)g.A + (size_t)nxt.pm * tstep : cA; const char* nB = has_next ? (const char*)g.Bt + (size_t)nxt.pn * tstep : cB;
        for (int t = 0; t < nt; t += 2) {
            const bool last = (t == nt - 2);
            const char* a1 = cA + (size_t)(t + 1) * kstep;
            const char* a2 = last ? nA : cA + (size_t)(t + 2) * kstep; const char* b2 = last ? nB : cB + (size_t)(t + 2) * kstep;
            const char* a3 = a2 + kstep; const char* b3 = b2 + kstep;
            if (last && has_next) S.a_ready(nxt);
            if constexpr (SP2) {
            PG8_LDB(B0, 0, 0); PG8_LDB(B1, 0, 1); PG8_SCHED; PG8_LDA(At, 0, 0); PG8_STAGE(PG8_SA(1, 1), a1 + hstep, voffA);
            PG8_WAIT_V(8); PG8_WAIT_L(0); PG8_BAR; PG8_MMA(0, 0, At, B0); PG8_MMA(0, 1, At, B1); PG8_BAR; PG8_SCHED;
            PG8_LDA(At, 0, 1); PG8_STAGE(PG8_SB(0, 0), b2, voffB); PG8_STAGE(PG8_SB(0, 1), b2 + hstep, voffB); PG8_STAGE(PG8_SA(0, 0), a2, voffA);
            PG8_WAIT_V(8); PG8_WAIT_L(0); PG8_BAR; PG8_MMA(1, 0, At, B0); PG8_MMA(1, 1, At, B1); PG8_BAR; PG8_SCHED;
            PG8_LDB(B0, 1, 0); PG8_LDB(B1, 1, 1); PG8_SCHED; PG8_LDA(At, 1, 0); PG8_STAGE(PG8_SA(0, 1), a2 + hstep, voffA);
            PG8_WAIT_V(8); PG8_WAIT_L(0); PG8_BAR; PG8_MMA(0, 0, At, B0); PG8_MMA(0, 1, At, B1); PG8_BAR; PG8_SCHED;
            PG8_LDA(At, 1, 1); PG8_STAGE(PG8_SB(1, 0), b3, voffB); PG8_STAGE(PG8_SB(1, 1), b3 + hstep, voffB); PG8_STAGE(PG8_SA(1, 0), a3, voffA);
            PG8_WAIT_V(8); PG8_WAIT_L(0); PG8_BAR; PG8_MMA(1, 0, At, B0); PG8_MMA(1, 1, At, B1); PG8_BAR; PG8_SCHED;
            } else {
            PG8_LDB(B0, 0, 0); PG8_SCHED; PG8_LDA(At, 0, 0); PG8_STAGE(PG8_SA(1, 1), a1 + hstep, voffA);
            PG8_WAIT_L(8); PG8_BAR; PG8_WAIT_L(0); PG8_MMA(0, 0, At, B0); PG8_BAR; PG8_SCHED;
            PG8_LDB(B1, 0, 1); PG8_STAGE(PG8_SB(0, 0), b2, voffB);
            PG8_BAR; PG8_WAIT_L(0); PG8_MMA(0, 1, At, B1); PG8_BAR;
            PG8_LDA(At, 0, 1); PG8_STAGE(PG8_SA(0, 0), a2, voffA);
            PG8_BAR; PG8_WAIT_L(0); PG8_MMA(1, 0, At, B0); PG8_BAR; PG8_SCHED;
            PG8_STAGE(PG8_SB(0, 1), b2 + hstep, voffB);
            PG8_WAIT_V(6); PG8_BAR; PG8_MMA(1, 1, At, B1); PG8_BAR;
            PG8_LDB(B0, 1, 0); PG8_SCHED; PG8_LDA(At, 1, 0); PG8_STAGE(PG8_SA(0, 1), a2 + hstep, voffA);
            PG8_WAIT_L(8); PG8_BAR; PG8_WAIT_L(0); PG8_MMA(0, 0, At, B0); PG8_BAR; PG8_SCHED;
            PG8_LDB(B1, 1, 1); PG8_STAGE(PG8_SB(1, 0), b3, voffB);
            PG8_BAR; PG8_WAIT_L(0); PG8_MMA(0, 1, At, B1); PG8_BAR;
            PG8_LDA(At, 1, 1); PG8_STAGE(PG8_SA(1, 0), a3, voffA);
            PG8_BAR; PG8_WAIT_L(0); PG8_MMA(1, 0, At, B0); PG8_BAR; PG8_SCHED;
            PG8_STAGE(PG8_SB(1, 1), b3 + hstep, voffB);
            PG8_WAIT_V(6); PG8_BAR; PG8_MMA(1, 1, At, B1); PG8_BAR;
            }
        }
        if constexpr (ALIGN_EPI) { if (wr == 0) PG8_BAR; }
        if constexpr (!Epi::AFTER_DRAIN) { E(acc, cur, wr, wc, fr, fq); S.done(cur); }
        if (!has_next) break;
#pragma unroll
        for (int a = 0; a < 2; ++a)
#pragma unroll
            for (int b = 0; b < 2; ++b)
#pragma unroll
                for (int m = 0; m < 4; ++m)
#pragma unroll
                    for (int n = 0; n < 2; ++n) acc[a][b][m][n] = (f32x4){0.f, 0.f, 0.f, 0.f};
        cur = nxt; cA = nA; cB = nB; ++ui;
        if constexpr (ALIGN_EPI) { if (wr == 1) PG8_BAR; }
    }
    PG8_WAIT_V(0);
    if constexpr (!ALIGN_EPI) { if (wr == 0) PG8_BAR; }
    PG8_BAR;
    if constexpr (Epi::AFTER_DRAIN) { E.fused(acc, cur, wr, wc, fr, fq, lds, wid, lane); S.done(cur); }
#undef PG8_SA
#undef PG8_SB
#undef PG8_STAGE
#undef PG8_LDA
#undef PG8_LDB
#undef PG8_MMA
#undef PG8_WAIT_V
#undef PG8_WAIT_L
#undef PG8_BAR
#undef PG8_SCHED
}
}

constexpr int NB = 8, SEQ = 4096, DM = 1024, M = NB * SEQ, NIN = 6144, DFF = 2816, NFI = 2 * DFF, NL = 2, CH = 128, NITEM = M / CH;
constexpr size_t MiB = 1u << 20;
constexpr size_t WS_RSS = 0, RSS_BYTES = 5 * (size_t)M * 4, WS_BAR = 768 * 1024, CTL_BYTES = 1u << 20;
constexpr size_t WS_WIN = 2 * MiB, WS_WOUT = 26 * MiB, WS_WFI = 30 * MiB, WS_WFO = 52 * MiB, WS_WG = 63 * MiB, WS_WSB = 65 * MiB, WS_AGG = 66 * MiB;
constexpr size_t WS_XB = 72 * MiB, WS_MG = 136 * MiB, WS_Z = 200 * MiB, WS_END = 456 * MiB;
#define LAS __attribute__((address_space(3)))
typedef unsigned short bf16;
typedef unsigned v4u __attribute__((ext_vector_type(4)));
typedef float f32x4 __attribute__((ext_vector_type(4)));
typedef float f32x16 __attribute__((ext_vector_type(16)));
typedef short bf16x8 __attribute__((ext_vector_type(8)));
__device__ __forceinline__ unsigned f2bf(float f) { unsigned u = __builtin_bit_cast(unsigned, f); return (u + 0x7fffu + ((u >> 16) & 1u)) >> 16; }
__device__ __forceinline__ unsigned pk2(float lo, float hi) { return f2bf(lo) | (f2bf(hi) << 16); }
__device__ __forceinline__ float bf2f(unsigned short h) { return __builtin_bit_cast(float, (unsigned)h << 16); }
__device__ __forceinline__ float bflo(unsigned w) { return __builtin_bit_cast(float, w << 16); }
__device__ __forceinline__ float bfhi(unsigned w) { return __builtin_bit_cast(float, w & 0xffff0000u); }
__device__ __forceinline__ float wave_sum(float v) {
#pragma unroll
    for (int o = 1; o < 64; o <<= 1) v += __shfl_xor(v, o);
    return v;
}
using pg8::sigm; using pg8::gelu_t;

constexpr int XS = 136;
constexpr int L_XC = 0, L_VT = 34816, L_HB = 69632, L_MB = 104448, L_EX = 139264, L_ST = 143360, L_CY = 144384, L_MISC = 152576, LDS_BYTES = 153600;

__device__ __forceinline__ void transpose_item(const float* W, int ldw, int srccol0, const float* gain, int k0, bf16* WT, int ldt, int dstrow0, LAS float* scr, int lane) {
#pragma unroll 8
    for (int i = 0; i < 32; ++i) { const int kk = 2 * i + (lane >> 5); float v = W[(size_t)(k0 + kk) * ldw + srccol0 + (lane & 31)]; if (gain) v *= gain[k0 + kk]; scr[kk * 33 + (lane & 31)] = v; }
    asm volatile("s_waitcnt lgkmcnt(0)" ::: "memory");
    const int c = lane & 7;
#pragma unroll
    for (int j = 0; j < 4; ++j) { const int n = (lane >> 3) + 8 * j; const LAS float* s = scr + (8 * c) * 33 + n;
        v4u o; o.x = pk2(s[0 * 33], s[1 * 33]); o.y = pk2(s[2 * 33], s[3 * 33]); o.z = pk2(s[4 * 33], s[5 * 33]); o.w = pk2(s[6 * 33], s[7 * 33]);
        *(v4u*)(WT + (size_t)(dstrow0 + n) * ldt + k0 + 8 * c) = o; }
    asm volatile("s_waitcnt lgkmcnt(0)" ::: "memory");
}
struct Ptrs {
    const float* in[19]; float* out; unsigned char* ws; unsigned long long pad;
};
__device__ __forceinline__ void prologue(const Ptrs& P, LAS unsigned char* lds, int tid, int lane, int wave) {
    LAS float* scr = (LAS float*)(lds + wave * 16384);
    const int gw = blockIdx.x * 8 + wave, NGW = gridDim.x * 8;
    constexpr int I_IN = 16 * 192, I_OUT = 16 * 32, I_FI = 16 * 176, I_FO = 44 * 32, I_G = 32 * 8, I_L = I_IN + I_OUT + I_FI + I_FO + I_G;
    for (int it = gw; it < NL * I_L; it += NGW) {
        const int l = it / I_L; int r = it % I_L;
        if (r < I_IN) {
            const int kb = r / 192, nb = r % 192, n0 = 32 * nb, j = n0 >> 8, i = n0 & 255; int src;
            if (j < 8) src = ((i >> 7) ? 4096 : 0) + 128 * j + (i & 127);
            else if (j < 12) src = 1024 + 256 * (j - 8) + i;
            else if (j < 16) src = 2048 + 256 * (j - 12) + i;
            else src = ((i >> 7) ? 5120 : 3072) + 128 * (j - 16) + (i & 127);
            transpose_item(P.in[2] + (size_t)l * DM * NIN, NIN, src, P.in[1] + l * DM, 64 * kb, (bf16*)(P.ws + WS_WIN) + (size_t)l * NIN * DM, DM, n0, scr, lane); continue; }
        r -= I_IN;
        if (r < I_OUT) { const int kb = r / 32, nb = r % 32;
            transpose_item(P.in[14] + (size_t)l * DM * DM, DM, 32 * nb, nullptr, 64 * kb, (bf16*)(P.ws + WS_WOUT) + (size_t)l * DM * DM, DM, 32 * nb, scr, lane); continue; }
        r -= I_OUT;
        if (r < I_FI) { const int kb = r / 176, nb = r % 176, n0 = 32 * nb, j = n0 >> 8, i = n0 & 255; const int src = (i >> 7) * DFF + 128 * j + (i & 127);
            transpose_item(P.in[16] + (size_t)l * DM * NFI, NFI, src, P.in[15] + l * DM, 64 * kb, (bf16*)(P.ws + WS_WFI) + (size_t)l * NFI * DM, DM, n0, scr, lane); continue; }
        r -= I_FI;
        if (r < I_FO) { const int kb = r / 32, nb = r % 32;
            transpose_item(P.in[17] + (size_t)l * DFF * DM, DM, 32 * nb, nullptr, 64 * kb, (bf16*)(P.ws + WS_WFO) + (size_t)l * DM * DFF, DFF, 32 * nb, scr, lane); continue; }
        r -= I_FO;
        {
            const int mi = r / 8, sub = r % 8, kb = sub / 4, nb = sub % 4, gate = mi & 1, h = (mi >> 1) & 7, d = mi >> 4;
            const float* src = (gate ? P.in[11] : P.in[9]) + ((size_t)((l * 2 + d) * 8 + h)) * CH * CH;
            transpose_item(src, CH, 32 * nb, nullptr, 64 * kb, (bf16*)(P.ws + WS_WG) + ((size_t)(l * 8 + h) * 512 + (d * 2 + gate) * 128) * CH, CH, 32 * nb, scr, lane);
        }
    }
    { const float* src = P.in[5]; bf16* dst = (bf16*)(P.ws + WS_WSB); const int n4 = NL * 8 * CH * CH / 4;
      for (int i = blockIdx.x * 512 + tid; i < n4; i += gridDim.x * 512) { const f32x4 v = *(const f32x4*)(src + 4 * (size_t)i); *(unsigned long long*)(dst + 4 * (size_t)i) = (unsigned long long)pk2(v.x, v.y) | ((unsigned long long)pk2(v.z, v.w) << 32); } }
    { const float* x = P.in[0]; bf16* xb = (bf16*)(P.ws + WS_XB); float* rss = (float*)(P.ws + WS_RSS);
      for (int m = gw; m < M; m += NGW) { const f32x4* xr = (const f32x4*)(x + (size_t)m * DM) + lane; unsigned long long* o8 = (unsigned long long*)(xb + (size_t)m * DM) + lane; float s = 0.f;
#pragma unroll
          for (int j = 0; j < 4; ++j) { const f32x4 v = xr[64 * j]; s += (v.x * v.x + v.y * v.y) + (v.z * v.z + v.w * v.w); o8[64 * j] = (unsigned long long)pk2(v.x, v.y) | ((unsigned long long)pk2(v.z, v.w) << 32); }
          s = wave_sum(s); if (lane == 0) rss[m] = s; } }
}
#define XB_TMO      128
#define XB_XCNT(j)  (256  + 64 * (j))
#define XB_XSUB(j)  (1280 + 64 * (j))
#define XB_XGEN(j)  (2304 + 64 * (j))
#define XB_TOP      3328
#define XB_TOPGEN   3392
#define XCD_BAR_WORDS 3456
#define XB_SPIN_CAP (1u << 18)

__device__ __forceinline__ unsigned xb_ld(unsigned* p)              { return __hip_atomic_load(p, __ATOMIC_RELAXED, __HIP_MEMORY_SCOPE_AGENT); }
__device__ __forceinline__ unsigned xb_add(unsigned* p, unsigned v) { return __hip_atomic_fetch_add(p, v, __ATOMIC_RELAXED, __HIP_MEMORY_SCOPE_AGENT); }
__device__ __forceinline__ unsigned xb_xcc_id() { return (unsigned)__builtin_amdgcn_s_getreg((3 << 11) | 20) & 0xFu; }
#define XB_SPIN(cond, bar) do { unsigned _sp = 0; while (cond) { __builtin_amdgcn_s_sleep(1); \
    if ((++_sp & 255u) == 0u) { if (xb_ld(&(bar)[XB_TMO])) break; if (_sp > XB_SPIN_CAP) { atomicAdd(&(bar)[XB_TMO], 1u); break; } } } } while (0)

struct XcdBarrier {
    unsigned* bar; unsigned x;
    volatile LAS unsigned* st;
};

__device__ __forceinline__ XcdBarrier xcd_barrier_post(unsigned* bar, volatile LAS unsigned* st) {
    XcdBarrier b; b.bar = bar; b.x = xb_xcc_id(); b.st = st;
    if (threadIdx.x == 0) (void)xb_add(&bar[XB_XCNT(b.x)], 1u);
    return b;
}
__device__ __forceinline__ void xcd_barrier_complete(unsigned* bar, unsigned x, unsigned& nloc, unsigned& nx) {
    const unsigned G = gridDim.x * gridDim.y * gridDim.z;
    unsigned sum, cnt, mine, sp = 0u;
    for (;;) {
        sum = 0u; cnt = 0u; mine = 0u;
#pragma unroll
        for (unsigned j = 0; j < 16; ++j) { const unsigned c = xb_ld(&bar[XB_XCNT(j)]); sum += c; cnt += (c > 0u) ? 1u : 0u; mine = (j == x) ? c : mine; }
        if (sum == G) break;
        __builtin_amdgcn_s_sleep(1);
        if ((++sp & 255u) == 0u) { if (xb_ld(&bar[XB_TMO])) break; if (sp > XB_SPIN_CAP) { atomicAdd(&bar[XB_TMO], 1u); break; } }
    }
    nloc = mine > 0u ? mine : 1u; nx = cnt > 0u ? cnt : 1u;
}

__device__ __forceinline__ void xcd_barrier(const XcdBarrier& b) {
    asm volatile("s_waitcnt vmcnt(0)" ::: "memory");
    __syncthreads();
    if (threadIdx.x == 0) {
        unsigned* bar = b.bar;
        __builtin_amdgcn_s_waitcnt(0);
        unsigned nloc = b.st[0], nx = b.st[1];
        if (nloc == 0u) { xcd_barrier_complete(bar, b.x, nloc, nx); b.st[0] = nloc; b.st[1] = nx; }
        const unsigned old = xb_add(&bar[XB_XSUB(b.x)], 1u);
        const unsigned gen = old / nloc;
        if (old + 1u == (gen + 1u) * nloc) {
            __builtin_amdgcn_fence(__ATOMIC_RELEASE, "agent");
            asm volatile("s_waitcnt vmcnt(0)" ::: "memory");
            const unsigned og = xb_add(&bar[XB_TOP], 1u);
            const unsigned tg = og / nx;
            if (og + 1u == (tg + 1u) * nx) xb_add(&bar[XB_TOPGEN], 1u);
            else XB_SPIN(xb_ld(&bar[XB_TOPGEN]) == tg, bar);
            __builtin_amdgcn_fence(__ATOMIC_ACQUIRE, "agent");
            xb_add(&bar[XB_XGEN(b.x)], 1u);
            asm volatile("s_waitcnt vmcnt(0)" ::: "memory");
        } else {
            XB_SPIN(xb_ld(&bar[XB_XGEN(b.x)]) == gen, bar);
            __builtin_amdgcn_fence(__ATOMIC_ACQUIRE, "agent");
            asm volatile("s_waitcnt vmcnt(0)" ::: "memory");
        }
    }
    __syncthreads();
}
struct MixP {
    const bf16* Z; bf16* MG; float* AGG; const bf16* WG; const bf16* WS;
    const float *lng, *lnb, *bs, *cw, *cb, *br, *bi, *lam;
};
template <int DIR> __device__ __forceinline__ void scan_a(const float (&a)[2][16], const float (&b)[2][16], int hw, float (&Pin)[8], float (&Hin)[8], float& Pt, float& Ht) {
    float Ar[8], Br[8];
#pragma unroll
    for (int k = 0; k < 8; ++k) { const int mb = k >> 2, q = (k & 3) * 4;
        const float a0 = a[mb][q], a1 = a[mb][q + 1], a2 = a[mb][q + 2], a3 = a[mb][q + 3], b0 = b[mb][q], b1 = b[mb][q + 1], b2 = b[mb][q + 2], b3 = b[mb][q + 3];
        Ar[k] = (a0 * a1) * (a2 * a3);
        Br[k] = DIR == 0 ? ((b0 * a1 + b1) * a2 + b2) * a3 + b3 : ((b3 * a2 + b2) * a1 + b1) * a0 + b0; }
    float P = 1.f, H = 0.f; const bool ownFirst = DIR == 0 ? (hw == 0) : (hw == 1);
#pragma unroll
    for (int kk = 0; kk < 8; ++kk) { const int k = DIR == 0 ? kk : 7 - kk;
        const float pA = __shfl_xor(Ar[k], 32), pB = __shfl_xor(Br[k], 32);
        const float fA = ownFirst ? Ar[k] : pA, fB = ownFirst ? Br[k] : pB, sA = ownFirst ? pA : Ar[k], sB = ownFirst ? pB : Br[k];
        const float P1 = P * fA, H1 = H * fA + fB;
        Pin[k] = ownFirst ? P : P1; Hin[k] = ownFirst ? H : H1;
        P = P1 * sA; H = H1 * sA + sB; }
    Pt = P; Ht = H;
}
template <int DIR> __device__ __forceinline__ void scan_b(const float (&a)[2][16], const float (&b)[2][16], const float (&Pin)[8], const float (&Hin)[8], float C, float (&h)[2][16]) {
#pragma unroll
    for (int k = 0; k < 8; ++k) { const int mb = k >> 2, q = (k & 3) * 4; const float cin = Pin[k] * C + Hin[k];
        if (DIR == 0) { const float h0 = a[mb][q] * cin + b[mb][q], h1 = a[mb][q + 1] * h0 + b[mb][q + 1], h2 = a[mb][q + 2] * h1 + b[mb][q + 2], h3 = a[mb][q + 3] * h2 + b[mb][q + 3];
            h[mb][q] = h0; h[mb][q + 1] = h1; h[mb][q + 2] = h2; h[mb][q + 3] = h3; }
        else { const float h3 = a[mb][q + 3] * cin + b[mb][q + 3], h2 = a[mb][q + 2] * h3 + b[mb][q + 2], h1 = a[mb][q + 1] * h2 + b[mb][q + 1], h0 = a[mb][q] * h1 + b[mb][q];
            h[mb][q] = h0; h[mb][q + 1] = h1; h[mb][q + 2] = h2; h[mb][q + 3] = h3; } }
}
__device__ __forceinline__ void gates_dir(LAS unsigned char* lds, const MixP& X, int h, int d, int cb, int th, int lane, float (&a)[2][16], float (&bt)[2][16]) {
    const int l31 = lane & 31, hw = lane >> 5;
    f32x16 ar[2], ai[2];
#pragma unroll
    for (int mb = 0; mb < 2; ++mb)
#pragma unroll
        for (int r = 0; r < 16; ++r) { ar[mb][r] = 0.f; ai[mb][r] = 0.f; }
    const bf16* wr_ = X.WG + ((size_t)h * 512 + d * 256 + 32 * cb + l31) * CH + 8 * hw;
    const bf16* wi_ = wr_ + 128 * CH;
    const LAS bf16* xa = (const LAS bf16*)(lds + L_XC) + (64 * th + l31) * XS + 8 * hw;
#pragma unroll
    for (int ks = 0; ks < 8; ++ks) {
        const bf16x8 br = *(const bf16x8*)(wr_ + 16 * ks), bi = *(const bf16x8*)(wi_ + 16 * ks);
#pragma unroll
        for (int mb = 0; mb < 2; ++mb) { const bf16x8 af = *(const LAS bf16x8*)(xa + 32 * mb * XS + 16 * ks);
            ar[mb] = __builtin_amdgcn_mfma_f32_32x32x16_bf16(af, br, ar[mb], 0, 0, 0); ai[mb] = __builtin_amdgcn_mfma_f32_32x32x16_bf16(af, bi, ai[mb], 0, 0, 0); }
    }
    const int ch = h * CH + 32 * cb + l31;
    const float brv = X.br[d * DM + ch], biv = X.bi[d * DM + ch], lam = X.lam[d * DM + ch];
    constexpr float L2E = 1.4426950408889634f;
    const float sp8n = -8.0f * L2E * log1pf(__expf(-lam)), brn = -L2E * brv, bin = -L2E * biv;
    const LAS bf16* xcol = (const LAS bf16*)(lds + L_XC) + (64 * th + 4 * hw) * XS + 32 * cb + l31;
#pragma unroll
    for (int mb = 0; mb < 2; ++mb)
#pragma unroll
        for (int r = 0; r < 16; ++r) { const int tw = 32 * mb + 8 * (r >> 2) + (r & 3);
            const float xv = bf2f(xcol[tw * XS]);
            const float rg = __builtin_amdgcn_rcpf(1.0f + __builtin_amdgcn_exp2f(__builtin_fmaf(ar[mb][r], -L2E, brn)));
            const float ig = __builtin_amdgcn_rcpf(1.0f + __builtin_amdgcn_exp2f(__builtin_fmaf(ai[mb][r], -L2E, bin)));
            const float av = __builtin_amdgcn_exp2f(sp8n * rg), mult = __builtin_amdgcn_sqrtf(__builtin_fmaxf(__builtin_fmaf(-av, av, 1.0f), 0.f));
            a[mb][r] = av; bt[mb][r] = mult * (ig * xv); }
}
template <int PASS> __device__ __forceinline__ void mixer_phase(LAS unsigned char* lds, const MixP& X, int tid, int lane, int wave) {
    const int cb = wave & 3, th = wave >> 2, l31 = lane & 31, hw = lane >> 5;
    LAS float* EX = (LAS float*)(lds + L_EX);
    LAS float* ST = (LAS float*)(lds + L_ST);
    LAS float* CY = (LAS float*)(lds + L_CY);
    for (int item = blockIdx.x; item < NITEM; item += gridDim.x) {
        const int n = item & 31; const size_t row0 = (size_t)item * CH;
        if (PASS == 2) {
            for (int i = 0; i < 16; ++i) { const int tok = wave * 16 + i; const bf16* vr = X.Z + (row0 + tok) * 4096 + 1024 + 8 * lane;
                const v4u w0 = *(const v4u*)vr, w1 = *(const v4u*)(vr + 512); float v[16];
                v[0] = bflo(w0.x); v[1] = bfhi(w0.x); v[2] = bflo(w0.y); v[3] = bfhi(w0.y); v[4] = bflo(w0.z); v[5] = bfhi(w0.z); v[6] = bflo(w0.w); v[7] = bfhi(w0.w);
                v[8] = bflo(w1.x); v[9] = bfhi(w1.x); v[10] = bflo(w1.y); v[11] = bfhi(w1.y); v[12] = bflo(w1.z); v[13] = bfhi(w1.z); v[14] = bflo(w1.w); v[15] = bfhi(w1.w);
                float s = 0.f;
#pragma unroll
                for (int j = 0; j < 16; ++j) s += v[j];
                const float mean = wave_sum(s) * (1.0f / 1024.0f); float q = 0.f;
#pragma unroll
                for (int j = 0; j < 16; ++j) { const float dd = v[j] - mean; q += dd * dd; }
                const float rstd = __builtin_amdgcn_rsqf(wave_sum(q) * (1.0f / 1024.0f) + 1e-6f);
                if (lane == 0) { ST[2 * tok] = mean; ST[2 * tok + 1] = rstd; } }
            for (int e = tid; e < 2048; e += 512) { const int d = e >> 10, ch = e & 1023; float c = 0.f;
                if (d == 0) { for (int m2 = 0; m2 < n; ++m2) { const float* ag = X.AGG + ((size_t)(item - n + m2) * 2 + 0) * 2048; c = ag[ch] * c + ag[1024 + ch]; } }
                else { for (int m2 = 31; m2 > n; --m2) { const float* ag = X.AGG + ((size_t)(item - n + m2) * 2 + 1) * 2048; c = ag[ch] * c + ag[1024 + ch]; } }
                CY[e] = c; }
            __syncthreads();
        }
        for (int h = 0; h < 8; ++h) {
            { const int c8 = tid & 15, chn = h * CH + 8 * c8; float w[4][8], cbv[8];
#pragma unroll
              for (int j = 0; j < 8; ++j) { cbv[j] = X.cb[chn + j];
#pragma unroll
                  for (int k = 0; k < 4; ++k) w[k][j] = X.cw[k * DM + chn + j]; }
#pragma unroll
              for (int i = 0; i < 4; ++i) { const int tok = (tid >> 4) + 32 * i, tp = n * CH + tok; float o[8];
#pragma unroll
                  for (int j = 0; j < 8; ++j) o[j] = cbv[j];
#pragma unroll
                  for (int k = 0; k < 4; ++k) { const int t2 = tp + k - 1;
                      if (t2 >= 0 && t2 < SEQ) { const v4u zz = *(const v4u*)(X.Z + (row0 + tok + k - 1) * 4096 + 2048 + chn);
                          o[0] += w[k][0] * bflo(zz.x); o[1] += w[k][1] * bfhi(zz.x); o[2] += w[k][2] * bflo(zz.y); o[3] += w[k][3] * bfhi(zz.y);
                          o[4] += w[k][4] * bflo(zz.z); o[5] += w[k][5] * bfhi(zz.z); o[6] += w[k][6] * bflo(zz.w); o[7] += w[k][7] * bfhi(zz.w); } }
                  v4u ov; ov.x = pk2(o[0], o[1]); ov.y = pk2(o[2], o[3]); ov.z = pk2(o[4], o[5]); ov.w = pk2(o[6], o[7]);
                  *(LAS v4u*)((LAS bf16*)(lds + L_XC) + tok * XS + 8 * c8) = ov; }
              if (PASS == 2) { float g[8], bb[8];
#pragma unroll
                  for (int j = 0; j < 8; ++j) { g[j] = X.lng[chn + j]; bb[j] = X.lnb[chn + j]; }
#pragma unroll
                  for (int i = 0; i < 4; ++i) { const int tok = (tid >> 4) + 32 * i; const v4u zz = *(const v4u*)(X.Z + (row0 + tok) * 4096 + 1024 + chn);
                      const float mean = ST[2 * tok], rstd = ST[2 * tok + 1]; float v[8];
                      v[0] = bflo(zz.x); v[1] = bfhi(zz.x); v[2] = bflo(zz.y); v[3] = bfhi(zz.y); v[4] = bflo(zz.z); v[5] = bfhi(zz.z); v[6] = bflo(zz.w); v[7] = bfhi(zz.w);
                      LAS bf16* vt = (LAS bf16*)(lds + L_VT) + (8 * c8) * XS + tok;
#pragma unroll
                      for (int j = 0; j < 8; ++j) vt[j * XS] = (bf16)f2bf((v[j] - mean) * rstd * g[j] + bb[j]); } }
            }
            __syncthreads();
            LAS bf16* hb = (LAS bf16*)(lds + L_HB) + (64 * th + 4 * hw) * XS + 32 * cb + l31;
            if (PASS == 2) {
                f32x16 am[2];
#pragma unroll
                for (int mb = 0; mb < 2; ++mb)
#pragma unroll
                    for (int r = 0; r < 16; ++r) am[mb][r] = 0.f;
                const bf16* wa = X.WS + ((size_t)h * CH + 64 * th + l31) * CH + 8 * hw;
                const LAS bf16* vb = (const LAS bf16*)(lds + L_VT) + (32 * cb + l31) * XS + 8 * hw;
#pragma unroll
                for (int ks = 0; ks < 8; ++ks) { const bf16x8 bf = *(const LAS bf16x8*)(vb + 16 * ks);
#pragma unroll
                    for (int mb = 0; mb < 2; ++mb) { const bf16x8 af = *(const bf16x8*)(wa + 32 * mb * CH + 16 * ks); am[mb] = __builtin_amdgcn_mfma_f32_32x32x16_bf16(af, bf, am[mb], 0, 0, 0); } }
                LAS bf16* mbp = (LAS bf16*)(lds + L_MB) + (64 * th + 4 * hw) * XS + 32 * cb + l31;
                const float* bsp = X.bs + h * CH + 64 * th + 4 * hw;
#pragma unroll
                for (int mb = 0; mb < 2; ++mb)
#pragma unroll
                    for (int r = 0; r < 16; ++r) { const int tw = 32 * mb + 8 * (r >> 2) + (r & 3); mbp[tw * XS] = (bf16)f2bf(am[mb][r] + bsp[tw]); }
            }
            {
                float a[2][16], bt[2][16], Pin[8], Hin[8], Pt, Ht;
                gates_dir(lds, X, h, 0, cb, th, lane, a, bt);
                scan_a<0>(a, bt, hw, Pin, Hin, Pt, Ht);
                if (hw == 0) { EX[((0 * 8 + wave) * 32 + l31) * 2] = Pt; EX[((0 * 8 + wave) * 32 + l31) * 2 + 1] = Ht; }
                if (PASS == 2) {
                    __syncthreads();
                    float C = CY[h * CH + 32 * cb + l31];
                    if (th == 1) { const float A0 = EX[((0 * 8 + cb) * 32 + l31) * 2], B0 = EX[((0 * 8 + cb) * 32 + l31) * 2 + 1]; C = A0 * C + B0; }
                    float hs[2][16];
                    scan_b<0>(a, bt, Pin, Hin, C, hs);
#pragma unroll
                    for (int mb = 0; mb < 2; ++mb)
#pragma unroll
                        for (int r = 0; r < 16; ++r) { const int tw = 32 * mb + 8 * (r >> 2) + (r & 3); hb[tw * XS] = (bf16)f2bf(hs[mb][r]); }
                }
            }
            {
                float a[2][16], bt[2][16], Pin[8], Hin[8], Pt, Ht;
                gates_dir(lds, X, h, 1, cb, th, lane, a, bt);
                scan_a<1>(a, bt, hw, Pin, Hin, Pt, Ht);
                if (hw == 0) { EX[((1 * 8 + wave) * 32 + l31) * 2] = Pt; EX[((1 * 8 + wave) * 32 + l31) * 2 + 1] = Ht; }
                __syncthreads();
                if (PASS == 2) {
                    float C = CY[1024 + h * CH + 32 * cb + l31];
                    if (th == 0) { const float A1 = EX[((1 * 8 + 4 + cb) * 32 + l31) * 2], B1 = EX[((1 * 8 + 4 + cb) * 32 + l31) * 2 + 1]; C = A1 * C + B1; }
                    float hs[2][16];
                    scan_b<1>(a, bt, Pin, Hin, C, hs);
#pragma unroll
                    for (int mb = 0; mb < 2; ++mb)
#pragma unroll
                        for (int r = 0; r < 16; ++r) { const int tw = 32 * mb + 8 * (r >> 2) + (r & 3); hb[tw * XS] = (bf16)f2bf(hs[mb][r] + bf2f(hb[tw * XS])); }
                }
            }
            if (PASS == 1) {
                if (tid < 256) { const int d = tid >> 7, c = tid & 127, cbb = c >> 5, cl = c & 31;
                    const float A0 = EX[((d * 8 + cbb) * 32 + cl) * 2], B0 = EX[((d * 8 + cbb) * 32 + cl) * 2 + 1], A1 = EX[((d * 8 + 4 + cbb) * 32 + cl) * 2], B1 = EX[((d * 8 + 4 + cbb) * 32 + cl) * 2 + 1];
                    float* ag = X.AGG + ((size_t)item * 2 + d) * 2048 + h * CH + c;
                    ag[0] = A0 * A1; ag[1024] = d == 0 ? (B0 * A1 + B1) : (B1 * A0 + B0); }
            } else {
                __syncthreads();
                { const int c8 = tid & 15, chn = h * CH + 8 * c8;
#pragma unroll
                  for (int i = 0; i < 4; ++i) { const int tok = (tid >> 4) + 32 * i; const bf16* zr = X.Z + (row0 + tok) * 4096 + chn;
                      const v4u pa = *(const v4u*)zr, qb = *(const v4u*)(zr + 3072);
                      const v4u hv = *(const LAS v4u*)((const LAS bf16*)(lds + L_HB) + tok * XS + 8 * c8), mv = *(const LAS v4u*)((const LAS bf16*)(lds + L_MB) + tok * XS + 8 * c8);
                      v4u o;
                      o.x = pk2(bflo(pa.x) * bflo(mv.x) + bflo(qb.x) * bflo(hv.x), bfhi(pa.x) * bfhi(mv.x) + bfhi(qb.x) * bfhi(hv.x));
                      o.y = pk2(bflo(pa.y) * bflo(mv.y) + bflo(qb.y) * bflo(hv.y), bfhi(pa.y) * bfhi(mv.y) + bfhi(qb.y) * bfhi(hv.y));
                      o.z = pk2(bflo(pa.z) * bflo(mv.z) + bflo(qb.z) * bflo(hv.z), bfhi(pa.z) * bfhi(mv.z) + bfhi(qb.z) * bfhi(hv.z));
                      o.w = pk2(bflo(pa.w) * bflo(mv.w) + bflo(qb.w) * bflo(hv.w), bfhi(pa.w) * bfhi(mv.w) + bfhi(qb.w) * bfhi(hv.w));
                      *(v4u*)(X.MG + (row0 + tok) * 1024 + chn) = o; } }
            }
        }
        __syncthreads();
    }
}
__global__ void __launch_bounds__(512, 2) fwd_megakernel(Ptrs P) {
    extern __shared__ __attribute__((aligned(16))) unsigned char lds_raw[];
    LAS unsigned char* lds = (LAS unsigned char*)lds_raw;
    cg::grid_group grid = cg::this_grid();
    const int tid = threadIdx.x, lane = tid & 63, wave = __builtin_amdgcn_readfirstlane(tid >> 6);
    unsigned char* ws = P.ws;
    float* rss = (float*)(ws + WS_RSS);
    bf16* XB = (bf16*)(ws + WS_XB); bf16* MG = (bf16*)(ws + WS_MG); bf16* Z = (bf16*)(ws + WS_Z); bf16* FF = (bf16*)(ws + WS_Z);
    const int G = (int)gridDim.x, c = (int)blockIdx.x;
    if (tid < 4) ((LAS unsigned*)(lds + L_MISC))[tid] = 0u;
    __syncthreads();
    const XcdBarrier bar = xcd_barrier_post((unsigned*)(ws + WS_BAR), (volatile LAS unsigned*)(lds + L_MISC));

#ifndef NO_PRO
    for (int rep = 0; rep < PROBE_PRO; ++rep) prologue(P, lds, tid, lane, wave);
#endif
    grid.sync();
    for (int rep = 1; rep < PROBE_SYNC; ++rep) xcd_barrier(bar);
    for (int l = 0; l < NL; ++l) {
        {
            pg8::Gemm g{XB, (const bf16*)(ws + WS_WIN) + (size_t)l * NIN * DM, M, NIN, DM}; pg8::StaticOrder S; S.init(M, NIN, G, c);
            pg8::EpiIn E{Z, rss + (size_t)(2 * l) * M};
#if !defined(NO_GEMM) && !defined(NO_G1)
            for (int rep = 0; rep < PROBE_G1; ++rep) pg8::gemm_phase<pg8::EpiIn, pg8::StaticOrder, true, true>(lds, g, S, E);
#endif
        }
        xcd_barrier(bar);
        MixP X; X.Z = Z; X.MG = MG; X.AGG = (float*)(ws + WS_AGG); X.WG = (const bf16*)(ws + WS_WG) + (size_t)l * 8 * 512 * CH; X.WS = (const bf16*)(ws + WS_WSB) + (size_t)l * 8 * CH * CH;
        X.lng = P.in[3] + l * DM; X.lnb = P.in[4] + l * DM; X.bs = P.in[6] + l * 8 * CH; X.cw = P.in[7] + l * 4 * DM; X.cb = P.in[8] + l * DM;
        X.br = P.in[10] + l * 2 * DM; X.bi = P.in[12] + l * 2 * DM; X.lam = P.in[13] + l * 2 * DM;
#ifndef NO_M1
        for (int rep = 0; rep < PROBE_M1; ++rep)
        { int t_ = threadIdx.x; asm volatile("" : "+v"(t_)); mixer_phase<1>(lds, X, t_, t_ & 63, __builtin_amdgcn_readfirstlane(t_ >> 6)); }
#endif
        xcd_barrier(bar);
#ifndef NO_M2
        for (int rep = 0; rep < PROBE_M2; ++rep)
        { int t_ = threadIdx.x; asm volatile("" : "+v"(t_)); mixer_phase<2>(lds, X, t_, t_ & 63, __builtin_amdgcn_readfirstlane(t_ >> 6)); }
#endif
        xcd_barrier(bar);
        {
            pg8::Gemm g{MG, (const bf16*)(ws + WS_WOUT) + (size_t)l * DM * DM, M, DM, DM}; pg8::StaticOrder S; S.init(M, DM, G, c);
            pg8::EpiRes E{l == 0 ? P.in[0] : (const float*)P.out, P.out, XB, rss + (size_t)(2 * l + 1) * M};
#if !defined(NO_GEMM) && !defined(NO_G2)
            pg8::gemm_phase<pg8::EpiRes, pg8::StaticOrder, true, true>(lds, g, S, E);
#endif
        }
        xcd_barrier(bar);
        {
            pg8::Gemm g{XB, (const bf16*)(ws + WS_WFI) + (size_t)l * NFI * DM, M, NFI, DM}; pg8::StaticOrder S; S.init(M, NFI, G, c);
            pg8::EpiFfn E{FF, rss + (size_t)(2 * l + 1) * M};
#if !defined(NO_GEMM) && !defined(NO_G3)
            for (int rep = 0; rep < PROBE_G3; ++rep) pg8::gemm_phase<pg8::EpiFfn, pg8::StaticOrder, true, true>(lds, g, S, E);
#endif
        }
        xcd_barrier(bar);
        {
            pg8::Gemm g{FF, (const bf16*)(ws + WS_WFO) + (size_t)l * DM * DFF, M, DM, DFF}; pg8::StaticOrder S; S.init(M, DM, G, c);
            pg8::EpiRes E{(const float*)P.out, P.out, XB, rss + (size_t)(2 * l + 2) * M};
#if !defined(NO_GEMM) && !defined(NO_G4)
            pg8::gemm_phase<pg8::EpiRes, pg8::StaticOrder, true, true>(lds, g, S, E);
#endif
        }
        xcd_barrier(bar);
    }
    { const float* fg = P.in[18]; const float* r4 = rss + (size_t)4 * M; const int gw = c * 8 + wave, NGW = G * 8;
      f32x4 gv[4];
#pragma unroll
      for (int j = 0; j < 4; ++j) gv[j] = *((const f32x4*)fg + lane + 64 * j);
      for (int m = gw; m < M; m += NGW) { f32x4* xr = (f32x4*)(P.out + (size_t)m * DM) + lane; const float s = __builtin_amdgcn_rsqf(r4[m] * (1.0f / 1024.0f) + 1e-6f);
#pragma unroll
          for (int j = 0; j < 4; ++j) { f32x4 v = xr[64 * j]; v = v * s * gv[j]; xr[64 * j] = v; } } }
}

extern "C" void kernel_launch(void* const* d_in, const int* in_sizes, int n_in, void* d_out, int out_size, void* d_ws, size_t ws_size, hipStream_t stream) {
    static int grid = 0;
    if (grid == 0) {
        if (n_in != 19 || in_sizes[0] != M * DM || out_size != M * DM || ws_size < WS_END) { fprintf(stderr, "kernel_launch: unexpected shapes / workspace (n_in %d, ws %zu)\n", n_in, ws_size); grid = -1; return; }
        int dev = 0, cus = 0, per_cu = 0;
        (void)hipGetDevice(&dev); (void)hipDeviceGetAttribute(&cus, hipDeviceAttributeMultiprocessorCount, dev);
        (void)hipFuncSetAttribute((const void*)fwd_megakernel, hipFuncAttributeMaxDynamicSharedMemorySize, LDS_BYTES);
        (void)hipOccupancyMaxActiveBlocksPerMultiprocessor(&per_cu, (const void*)fwd_megakernel, 512, LDS_BYTES);
        if (per_cu < 1) { fprintf(stderr, "kernel_launch: occupancy query says %d blocks per CU\n", per_cu); per_cu = 1; }
        (void)hipGetLastError();
        grid = cus * 1;
    }
    if (grid < 0) return;
    (void)hipMemsetAsync((char*)d_ws + WS_RSS, 0, CTL_BYTES, stream);
    Ptrs p{};
    for (int i = 0; i < 19; ++i) p.in[i] = (const float*)d_in[i];
    p.out = (float*)d_out; p.ws = (unsigned char*)d_ws; p.pad = 0;
    void* args[] = {&p};
    hipError_t e = hipLaunchCooperativeKernel((const void*)fwd_megakernel, dim3(grid), dim3(512), args, LDS_BYTES, stream);
    if (e != hipSuccess) fprintf(stderr, "cooperative launch failed: %s (grid %d)\n", hipGetErrorString(e), grid);
}
```
